# Optimizing an MI355X kernel written in HIP

```python
import jax, jax.numpy as jnp
from jax import lax
import numpy as np

D_MODEL = 1024
BATCH = 8
SEQ = 2048
DEPTH = 4
DEC_BATCH = 8
DEC_SEQ = 32
PAST_LEN = 1024

CHUNK = 64
Q_BLOCK = 128
D_HEAD = 64
H_A = (D_MODEL // 2) // D_HEAD
B_WIDTH = D_MODEL // 2
G_B = 4
B_CHUNK = 128
H_C = (D_MODEL // 2) // D_HEAD
KV_C = max(1, H_C // 4)
H_IDX = 4
D_IDX = 64
TOPK_MAX = 256
D_D = D_MODEL // 2
CONV_W = 3
D_FF = 4 * D_MODEL
N_EVEN = (DEPTH + 1) // 2
N_ODD = DEPTH // 2
EPS = 1e-6
NEG = -1e30
EVEN_SPLITS = (H_A * D_HEAD, H_A * D_HEAD, H_A * D_HEAD, B_WIDTH, B_WIDTH)
ODD_SPLITS = (H_C * D_HEAD, KV_C * D_HEAD, KV_C * D_HEAD, H_IDX * D_IDX, D_IDX, H_IDX, D_D, D_D, D_D)
EVEN_IN = sum(EVEN_SPLITS)
ODD_IN = sum(ODD_SPLITS)
MIX_OUT = H_A * D_HEAD + B_WIDTH

kernel_name = 'hybrid_streaming_encoder_step'


def rms_norm(x, g):
    xf = x.astype(jnp.float32)
    y = xf * lax.rsqrt(jnp.mean(xf * xf, axis=-1, keepdims=True) + EPS)
    return (y * g.astype(jnp.float32)).astype(x.dtype)


def split_cols(z, sizes):
    offs = np.cumsum((0,) + tuple(sizes))
    return [z[..., int(offs[i]):int(offs[i + 1])] for i in range(len(sizes))]


def to_blocks(a):
    b, s = a.shape[:2]
    return jnp.moveaxis(a.reshape((b, s // Q_BLOCK, Q_BLOCK) + a.shape[2:]), 1, 0)


def from_blocks(a):
    nb, b, qb = a.shape[:3]
    return jnp.moveaxis(a, 0, 1).reshape((b, nb * qb) + a.shape[3:])


def stick_breaking(q, k, v, q_pos, k_pos):
    f32 = jnp.float32
    z = jnp.einsum('bqhd,bkhd->bhqk', q.astype(f32), k.astype(f32)) * (D_HEAD ** -0.5)
    mask = k_pos[None, :] < q_pos[:, None]
    log_stay = jnp.where(mask, jax.nn.log_sigmoid(-z), 0.0)
    csum = jnp.cumsum(log_stay, axis=-1)
    after = csum[..., -1:] - csum
    w = jnp.where(mask, jnp.exp(jax.nn.log_sigmoid(z) + after), 0.0)
    return jnp.einsum('bhqk,bkhd->bqhd', w.astype(v.dtype), v)


def dsa_attend(q, qi, wi, q_pos, k, v, ki, k_pos, top_k):
    f32 = jnp.float32
    qk_idx = jnp.einsum('bqhe,bke->bqhk', qi.astype(f32), ki.astype(f32)) * (D_IDX ** -0.5)
    score = jnp.einsum('bqhk,bqh->bqk', jax.nn.relu(qk_idx), wi.astype(f32)) * (H_IDX ** -0.5)
    admissible = (k_pos[None, :] // CHUNK) <= (q_pos[:, None] // CHUNK)
    score = jnp.where(admissible, score, NEG)
    _, idx = lax.top_k(score, top_k)
    gather = jax.vmap(lambda rows, ii: rows[ii])
    k_sel = gather(k, idx)
    v_sel = gather(v, idx)
    sel_ok = (k_pos[idx] // CHUNK) <= (q_pos[None, :, None] // CHUNK)
    b_, nq = q.shape[:2]
    qg = q.reshape(b_, nq, KV_C, H_C // KV_C, D_HEAD)
    logits = jnp.einsum('bqgrd,bqkgd->bqgrk', qg.astype(f32), k_sel.astype(f32)) * (D_HEAD ** -0.5)
    logits = jnp.where(sel_ok[:, :, None, None, :], logits, NEG)
    p = jax.nn.softmax(logits, axis=-1)
    out = jnp.einsum('bqgrk,bqkgd->bqgrd', p.astype(v.dtype), v_sel)
    return out.reshape(b_, nq, H_C, D_HEAD)


def spatial_gate(u, vb, ws, bs, fresh_partial):
    pos = jnp.arange(B_CHUNK)
    causal = (pos[None, :] // CHUNK) <= (pos[:, None] // CHUNK)
    w = ws * causal.astype(ws.dtype)
    b_, t = vb.shape[:2]
    cg = B_WIDTH // G_B
    if fresh_partial:
        vr = vb.reshape(b_, 1, t, G_B, cg)
        w = w[:, :t, :t]
        bias = bs[:, :t]
    else:
        vr = vb.reshape(b_, t // B_CHUNK, B_CHUNK, G_B, cg)
        bias = bs
    mixed = jnp.einsum('gpq,bnqgc->bnpgc', w, vr) + bias.T[:, :, None]
    return u * mixed.reshape(b_, t, B_WIDTH)


def short_conv(cin, conv_w, prev):
    b_, t = cin.shape[:2]
    if prev is None:
        prev = jnp.zeros((b_, CONV_W - 1, D_D), cin.dtype)
    padded = jnp.concatenate([prev, cin], axis=1)
    y = conv_w[0] * padded[:, 0:t]
    for j in range(1, CONV_W):
        y = y + conv_w[j] * padded[:, j:j + t]
    return y, padded[:, t:]


def even_mixer(h, w_in, gq, gk, gb, ws, bs, w_out, past_k=None, past_v=None):
    b_, t = h.shape[:2]
    q, k, v, u, vb = split_cols(h @ w_in, EVEN_SPLITS)
    q = rms_norm(q.reshape(b_, t, H_A, D_HEAD), gq)
    k = rms_norm(k.reshape(b_, t, H_A, D_HEAD), gk)
    v = v.reshape(b_, t, H_A, D_HEAD)
    if past_k is None:
        pos = jnp.arange(t)
        att = from_blocks(lax.map(lambda a: stick_breaking(a[0], k, v, a[1], pos),
                                  (to_blocks(q), pos.reshape(-1, Q_BLOCK))))
    else:
        p = past_k.shape[1]
        att = stick_breaking(q, jnp.concatenate([past_k, k], axis=1),
                             jnp.concatenate([past_v, v], axis=1),
                             p + jnp.arange(t), jnp.arange(p + t))
    u = jax.nn.gelu(u)
    vb = rms_norm(jax.nn.gelu(vb), gb)
    gated = spatial_gate(u, vb, ws, bs, past_k is not None)
    out = jnp.concatenate([att.reshape(b_, t, -1), gated], axis=-1) @ w_out
    return out, k, v, vb


def odd_mixer(h, w_in, gq, gk, conv_w, w_out, past_k=None, past_v=None, past_ki=None, past_conv=None):
    b_, t = h.shape[:2]
    q, k, v, qi, ki, wi, gate_b, gate_c, hd = split_cols(h @ w_in, ODD_SPLITS)
    q = rms_norm(q.reshape(b_, t, H_C, D_HEAD), gq)
    k = rms_norm(k.reshape(b_, t, KV_C, D_HEAD), gk)
    v = v.reshape(b_, t, KV_C, D_HEAD)
    qi = qi.reshape(b_, t, H_IDX, D_IDX)
    if past_k is None:
        pos = jnp.arange(t)
        top_k = min(TOPK_MAX, t // 4)
        att = from_blocks(lax.map(lambda a: dsa_attend(a[0], a[1], a[2], a[3], k, v, ki, pos, top_k),
                                  (to_blocks(q), to_blocks(qi), to_blocks(wi), pos.reshape(-1, Q_BLOCK))))
    else:
        p = past_k.shape[1]
        top_k = min(TOPK_MAX, (p + t) // 4)
        att = dsa_attend(q, qi, wi, p + jnp.arange(t),
                         jnp.concatenate([past_k, k], axis=1),
                         jnp.concatenate([past_v, v], axis=1),
                         jnp.concatenate([past_ki, ki], axis=1),
                         jnp.arange(p + t), top_k)
    conv, new_conv = short_conv(gate_c * hd, conv_w, past_conv)
    out = jnp.concatenate([att.reshape(b_, t, -1), gate_b * conv], axis=-1) @ w_out
    return out, k, v, ki, new_conv


def sq_relu_ffn(h, w1, w2):
    return jnp.square(jax.nn.relu(h @ w1)) @ w2


def setup_inputs(seed: int = 0) -> dict:
    key = jax.random.key(seed)
    ks = iter(jax.random.split(key, 32))

    def nrm(shape, scale=1.0):
        return jax.random.normal(next(ks), shape, jnp.float32) * scale

    def gain(shape):
        return 1.0 + 0.05 * nrm(shape)

    return {
        'x_prompt': nrm((BATCH, SEQ, D_MODEL)),
        'x_sample': nrm((DEC_BATCH, DEC_SEQ, D_MODEL)),
        'cache_a_k': nrm((N_EVEN, DEC_BATCH, PAST_LEN, H_A, D_HEAD)),
        'cache_a_v': nrm((N_EVEN, DEC_BATCH, PAST_LEN, H_A, D_HEAD)),
        'cache_c_k': nrm((N_ODD, DEC_BATCH, PAST_LEN, KV_C, D_HEAD)),
        'cache_c_v': nrm((N_ODD, DEC_BATCH, PAST_LEN, KV_C, D_HEAD)),
        'cache_c_kidx': nrm((N_ODD, DEC_BATCH, PAST_LEN, D_IDX)),
        'state_d_conv': nrm((N_ODD, DEC_BATCH, CONV_W - 1, D_D)),
        'norm_mix_g': gain((DEPTH, D_MODEL)),
        'norm_ffn_g': gain((DEPTH, D_MODEL)),
        'w_in_even': nrm((N_EVEN, D_MODEL, EVEN_IN), D_MODEL ** -0.5),
        'gq_a': gain((N_EVEN, D_HEAD)),
        'gk_a': gain((N_EVEN, D_HEAD)),
        'g_b': gain((N_EVEN, B_WIDTH)),
        'ws_b': nrm((N_EVEN, G_B, B_CHUNK, B_CHUNK), B_CHUNK ** -0.5),
        'bs_b': gain((N_EVEN, G_B, B_CHUNK)),
        'w_out_even': nrm((N_EVEN, MIX_OUT, D_MODEL), MIX_OUT ** -0.5),
        'w_in_odd': nrm((N_ODD, D_MODEL, ODD_IN), D_MODEL ** -0.5),
        'gq_c': gain((N_ODD, D_HEAD)),
        'gk_c': gain((N_ODD, D_HEAD)),
        'conv_w_d': nrm((N_ODD, CONV_W, D_D), CONV_W ** -0.5),
        'w_out_odd': nrm((N_ODD, MIX_OUT, D_MODEL), MIX_OUT ** -0.5),
        'w_ffn1': nrm((DEPTH, D_MODEL, D_FF), D_MODEL ** -0.5),
        'w_ffn2': nrm((DEPTH, D_FF, D_MODEL), D_FF ** -0.5),
    }


def reference(x_prompt, x_sample, cache_a_k, cache_a_v, cache_c_k, cache_c_v, cache_c_kidx, state_d_conv,
              norm_mix_g, norm_ffn_g, w_in_even, gq_a, gk_a, g_b, ws_b, bs_b, w_out_even,
              w_in_odd, gq_c, gk_c, conv_w_d, w_out_odd, w_ffn1, w_ffn2):
    xp, xs = x_prompt, x_sample
    ak_p, av_p, ak_s, av_s, bv_s = [], [], [], [], []
    ck_p, cv_p, ci_p, ck_s, cv_s, ci_s, dc_p, dc_s = [], [], [], [], [], [], [], []
    for i in range(DEPTH):
        j = i // 2
        hp = rms_norm(xp, norm_mix_g[i])
        hs = rms_norm(xs, norm_mix_g[i])
        if i % 2 == 0:
            lw = (w_in_even[j], gq_a[j], gk_a[j], g_b[j], ws_b[j], bs_b[j], w_out_even[j])
            mp, kp, vp, _ = even_mixer(hp, *lw)
            ms, ks_, vs_, vbs = even_mixer(hs, *lw, past_k=cache_a_k[j], past_v=cache_a_v[j])
            ak_p.append(kp); av_p.append(vp)
            ak_s.append(ks_); av_s.append(vs_); bv_s.append(vbs)
        else:
            lw = (w_in_odd[j], gq_c[j], gk_c[j], conv_w_d[j], w_out_odd[j])
            mp, kp, vp, kip, cvp = odd_mixer(hp, *lw)
            ms, ks_, vs_, kis, cvs = odd_mixer(hs, *lw, past_k=cache_c_k[j], past_v=cache_c_v[j],
                                               past_ki=cache_c_kidx[j], past_conv=state_d_conv[j])
            ck_p.append(kp); cv_p.append(vp); ci_p.append(kip); dc_p.append(cvp)
            ck_s.append(ks_); cv_s.append(vs_); ci_s.append(kis); dc_s.append(cvs)
        xp = xp + mp
        xs = xs + ms
        xp = xp + sq_relu_ffn(rms_norm(xp, norm_ffn_g[i]), w_ffn1[i], w_ffn2[i])
        xs = xs + sq_relu_ffn(rms_norm(xs, norm_ffn_g[i]), w_ffn1[i], w_ffn2[i])
    return (xp, xs,
            jnp.stack(ak_p), jnp.stack(av_p), jnp.stack(ak_s), jnp.stack(av_s),
            jnp.stack(bv_s),
            jnp.stack(ck_p), jnp.stack(cv_p), jnp.stack(ci_p),
            jnp.stack(ck_s), jnp.stack(cv_s), jnp.stack(ci_s),
            jnp.stack(dc_p), jnp.stack(dc_s))
```

```cpp
#include <hip/hip_runtime.h>
#include <hip/hip_cooperative_groups.h>
#include <cstdio>
#include <cstdint>
#include <cstddef>
namespace cg = cooperative_groups;
namespace pg8 {
#define PG8_LAS __attribute__((address_space(3)))
typedef unsigned short bf16_t;
typedef short bf16x8 __attribute__((ext_vector_type(8)));
typedef float f32x4 __attribute__((ext_vector_type(4)));
typedef unsigned u32x4 __attribute__((ext_vector_type(4)));
constexpr int BM = 256, BK = 64, HALF = 128, HTB = HALF * BK * 2  , STAGE_BYTES = 8 * HTB, NXCD = 8, WGM = 8;

__host__ __device__ __forceinline__ int lds_byte(int r, int c) { const int st = (r >> 4) * 2 + (c >> 5), rr = r & 15, cc = c & 31, ob = rr * 64 + cc * 2; return st * 1024 + (ob ^ (((ob >> 9) & 1) << 5)); }
__host__ __device__ __forceinline__ void stage_rc(int b, int& R, int& C) { const int st = b / 1024, sb = b % 1024, swz = sb ^ (((sb >> 9) & 1) << 5); R = (st >> 1) * 16 + swz / 64; C = (st & 1) * 32 + (swz % 64) / 2; }
__host__ __device__ __forceinline__ int perm32(int rho) { const int n = rho >> 4, i = rho & 15; return 8 * (i >> 2) + 4 * n + (i & 3); }

struct Unit { int pm, pn; };
struct Gemm { const bf16_t* A; const bf16_t* Bt; int M, N, K; };

struct StaticOrder {
    int nM, nN, nwg, G, c;
    __host__ __device__ void init(int M, int N, int G_, int c_) { nM = M / BM; nN = N / BM; nwg = nM * nN; G = G_; c = c_; }
    __host__ __device__ bool next(int i, Unit& u) const {
        const long L = (long)i * G + c; if (L >= nwg) return false;
        int wgid = (int)L; { const int q = nwg / NXCD, r = nwg % NXCD, xcd = wgid % NXCD, off = wgid / NXCD; wgid = (xcd < r ? xcd * (q + 1) : r * (q + 1) + (xcd - r) * q) + off; }
        const int nig = WGM * nN, gid = wgid / nig, fm = gid * WGM, gsz = (nM - fm) < WGM ? (nM - fm) : WGM;
        u.pm = fm + ((wgid % nig) % gsz); u.pn = (wgid % nig) / gsz; return true;
    }
    __device__ __forceinline__ void a_ready(const Unit&) const {}
    __device__ __forceinline__ void done(const Unit&) const {}
};

__device__ __forceinline__ unsigned cvt_pk_bf16(float lo, float hi) { unsigned r; asm volatile("v_cvt_pk_bf16_f32 %0, %1, %2" : "=v"(r) : "v"(lo), "v"(hi)); return r; }
template <int ACT  > struct EpiBf16 {
    static constexpr bool PERM = true, AFTER_DRAIN = false;
    bf16_t* O; int ldc;
    __device__ __forceinline__ void operator()(const f32x4 (&acc)[2][2][4][2], const Unit& u, int wr, int wc, int fr, int fq) const {
        const int row0 = u.pm * BM + wr * 64 + fr, col0 = u.pn * BM + wc * 32 + 8 * fq;
#pragma unroll
        for (int ai = 0; ai < 2; ++ai)
#pragma unroll
            for (int m = 0; m < 4; ++m) { bf16_t* rowp = O + (size_t)(row0 + ai * HALF + m * 16) * ldc + col0;
#pragma unroll
                for (int bj = 0; bj < 2; ++bj) { f32x4 v0 = acc[ai][bj][m][0], v1 = acc[ai][bj][m][1];
                    if (ACT == 2) {
#pragma unroll
                        for (int e = 0; e < 4; ++e) { const float a0 = fmaxf(v0[e], 0.f), a1 = fmaxf(v1[e], 0.f); v0[e] = a0 * a0; v1[e] = a1 * a1; } }
                    u32x4 w; w.x = cvt_pk_bf16(v0[0], v0[1]); w.y = cvt_pk_bf16(v0[2], v0[3]); w.z = cvt_pk_bf16(v1[0], v1[1]); w.w = cvt_pk_bf16(v1[2], v1[3]);
                    *(u32x4*)(rowp + bj * HALF) = w; } }
    }
};
struct EpiRes {
    static constexpr bool PERM = false, AFTER_DRAIN = false;
    float* X; int ldc;
    __device__ __forceinline__ void operator()(const f32x4 (&acc)[2][2][4][2], const Unit& u, int wr, int wc, int fr, int fq) const {
        const int row0 = u.pm * BM + wr * 64 + fr, col0 = u.pn * BM + wc * 32 + 4 * fq;
        f32x4 cur[4], nxt[4];
        { const float* rowp = X + (size_t)row0 * ldc + col0;
#pragma unroll
          for (int q = 0; q < 4; ++q) cur[q] = *(const f32x4*)(rowp + (q >> 1) * HALF + (q & 1) * 16); }
#pragma unroll
        for (int gidx = 0; gidx < 8; ++gidx) { const int ai = gidx >> 2, m = gidx & 3;
            float* rowp = X + (size_t)(row0 + ai * HALF + m * 16) * ldc + col0;
            if (gidx < 7) { const int ai2 = (gidx + 1) >> 2, m2 = (gidx + 1) & 3; const float* rp2 = X + (size_t)(row0 + ai2 * HALF + m2 * 16) * ldc + col0;
#pragma unroll
                for (int q = 0; q < 4; ++q) nxt[q] = *(const f32x4*)(rp2 + (q >> 1) * HALF + (q & 1) * 16); }
#pragma unroll
            for (int q = 0; q < 4; ++q) *(f32x4*)(rowp + (q >> 1) * HALF + (q & 1) * 16) = cur[q] + acc[ai][q >> 1][m][q & 1];
            asm volatile("" ::: "memory");
#pragma unroll
            for (int q = 0; q < 4; ++q) cur[q] = nxt[q]; }
    }
};
template <class Epi, class Sched, bool ALIGN_EPI = false, bool SP2 = false>
__device__ __forceinline__ void gemm_phase(PG8_LAS unsigned char* lds, const Gemm g, const Sched& S, const Epi& E, int wid_in) {
    int tid_l = threadIdx.x; asm volatile("" : "+v"(tid_l));
    const int tid = tid_l, wid = __builtin_amdgcn_readfirstlane(tid >> 6), lane = tid & 63, wr = wid >> 2, wc = wid & 3, fr = lane & 15, fq = lane >> 4;
    const int K = g.K, nt = K / BK;
    unsigned voffA[2], voffB[2];
#pragma unroll
    for (int i = 0; i < 2; ++i) { int R, C; stage_rc(tid * 16 + i * 8192, R, C); const int Rb = Epi::PERM ? ((R & ~31) + perm32(R & 31)) : R;
        voffA[i] = (unsigned)(R * K + C) * 2u; voffB[i] = (unsigned)(Rb * K + C) * 2u; }
    const size_t kstep = (size_t)(BK * 2);
    const size_t hstep = (size_t)HALF * K * 2;
    const size_t tstep = 2 * hstep;
    const unsigned ldsw = (unsigned)wid * 1024u;
    const int aoff = lds_byte(wr * 64 + fr, fq * 8), boff = lds_byte(wc * 32 + fr, fq * 8);
#define PG8_SA(b, h) (((b) * 2 + (h)) * HTB)
#define PG8_SB(b, h) ((4 + (b) * 2 + (h)) * HTB)
#define PG8_STAGE(bufoff, gbase, voff) do { _Pragma("unroll") for (int _i = 0; _i < 2; ++_i) \
        __builtin_amdgcn_global_load_lds((const unsigned*)((const char*)(gbase) + (voff)[_i]), (PG8_LAS unsigned*)(lds + (bufoff) + ldsw + _i * 8192), 16, 0, 0); } while (0)
#define PG8_LDA(dst, b, h) do { _Pragma("unroll") for (int m = 0; m < 4; ++m) _Pragma("unroll") for (int k = 0; k < 2; ++k) dst[m][k] = *(const PG8_LAS bf16x8*)(lds + PG8_SA(b, h) + aoff + m * 2048 + k * 1024); } while (0)
#define PG8_LDB(dst, b, h) do { _Pragma("unroll") for (int n = 0; n < 2; ++n) _Pragma("unroll") for (int k = 0; k < 2; ++k) dst[n][k] = *(const PG8_LAS bf16x8*)(lds + PG8_SB(b, h) + boff + n * 2048 + k * 1024); } while (0)
#define PG8_MMA(ai, bj, At, Bt) do { __builtin_amdgcn_s_setprio(1); _Pragma("unroll") for (int m = 0; m < 4; ++m) _Pragma("unroll") for (int n = 0; n < 2; ++n) _Pragma("unroll") for (int k = 0; k < 2; ++k) \
        acc[ai][bj][m][n] = __builtin_amdgcn_mfma_f32_16x16x32_bf16(Bt[n][k], At[m][k], acc[ai][bj][m][n], 0, 0, 0); __builtin_amdgcn_s_setprio(0); } while (0)
#define PG8_WAIT_V(n) asm volatile("s_waitcnt vmcnt(" #n ")" ::: "memory")
#define PG8_WAIT_L(n) asm volatile("s_waitcnt lgkmcnt(" #n ")" ::: "memory")
#define PG8_BAR __builtin_amdgcn_s_barrier()
#define PG8_SCHED __builtin_amdgcn_sched_barrier(0)
    Unit cur, nxt; int ui = 0;
    if (!S.next(0, cur)) return;
    f32x4 acc[2][2][4][2];
#pragma unroll
    for (int a = 0; a < 2; ++a)
#pragma unroll
        for (int b = 0; b < 2; ++b)
#pragma unroll
            for (int m = 0; m < 4; ++m)
#pragma unroll
                for (int n = 0; n < 2; ++n) acc[a][b][m][n] = (f32x4){0.f, 0.f, 0.f, 0.f};
    bf16x8 At[4][2], B0[2][2], B1[2][2];
    const char* cA = (const char*)g.A + (size_t)cur.pm * tstep; const char* cB = (const char*)g.Bt + (size_t)cur.pn * tstep;
    S.a_ready(cur);
    if constexpr (SP2) {
        PG8_STAGE(PG8_SB(0, 0), cB, voffB); PG8_STAGE(PG8_SB(0, 1), cB + hstep, voffB); PG8_STAGE(PG8_SA(0, 0), cA, voffA); PG8_STAGE(PG8_SA(0, 1), cA + hstep, voffA);
        if (wr == 1) PG8_BAR;
        PG8_WAIT_V(2); PG8_BAR;
        PG8_STAGE(PG8_SB(1, 0), cB + kstep, voffB); PG8_STAGE(PG8_SA(1, 0), cA + kstep, voffA); PG8_STAGE(PG8_SB(1, 1), cB + hstep + kstep, voffB);
        PG8_WAIT_V(6); PG8_BAR;
    } else {
        PG8_STAGE(PG8_SB(0, 0), cB, voffB); PG8_STAGE(PG8_SA(0, 0), cA, voffA); PG8_STAGE(PG8_SB(0, 1), cB + hstep, voffB); PG8_STAGE(PG8_SA(0, 1), cA + hstep, voffA);
        if (wr == 1) PG8_BAR;
        PG8_WAIT_V(4); PG8_BAR;
        PG8_STAGE(PG8_SB(1, 0), cB + kstep, voffB); PG8_STAGE(PG8_SA(1, 0), cA + kstep, voffA); PG8_STAGE(PG8_SB(1, 1), cB + hstep + kstep, voffB);
        PG8_WAIT_V(6); PG8_BAR;
    }
    for (;;) {
        const bool has_next = S.next(ui + 1, nxt);
        const char* nA = has_next ? (const char*)g.A + (size_t)nxt.pm * tstep : cA; const char* nB = has_next ? (const char*)g.Bt + (size_t)nxt.pn * tstep : cB;
        for (int t = 0; t < nt; t += 2) {
            const bool last = (t == nt - 2);
            const char* a1 = cA + (size_t)(t + 1) * kstep;
            const char* a2 = last ? nA : cA + (size_t)(t + 2) * kstep; const char* b2 = last ? nB : cB + (size_t)(t + 2) * kstep;
            const char* a3 = a2 + kstep; const char* b3 = b2 + kstep;
            if (last && has_next) S.a_ready(nxt);
            if constexpr (SP2) {
            PG8_LDB(B0, 0, 0); PG8_LDB(B1, 0, 1); PG8_SCHED; PG8_LDA(At, 0, 0); PG8_STAGE(PG8_SA(1, 1), a1 + hstep, voffA);
            PG8_WAIT_V(8); PG8_WAIT_L(0); PG8_BAR; PG8_MMA(0, 0, At, B0); PG8_MMA(0, 1, At, B1); PG8_BAR; PG8_SCHED;
            PG8_LDA(At, 0, 1); PG8_STAGE(PG8_SB(0, 0), b2, voffB); PG8_STAGE(PG8_SB(0, 1), b2 + hstep, voffB); PG8_STAGE(PG8_SA(0, 0), a2, voffA);
            PG8_WAIT_V(8); PG8_WAIT_L(0); PG8_BAR; PG8_MMA(1, 0, At, B0); PG8_MMA(1, 1, At, B1); PG8_BAR; PG8_SCHED;
            PG8_LDB(B0, 1, 0); PG8_LDB(B1, 1, 1); PG8_SCHED; PG8_LDA(At, 1, 0); PG8_STAGE(PG8_SA(0, 1), a2 + hstep, voffA);
            PG8_WAIT_V(8); PG8_WAIT_L(0); PG8_BAR; PG8_MMA(0, 0, At, B0); PG8_MMA(0, 1, At, B1); PG8_BAR; PG8_SCHED;
            PG8_LDA(At, 1, 1); PG8_STAGE(PG8_SB(1, 0), b3, voffB); PG8_STAGE(PG8_SB(1, 1), b3 + hstep, voffB); PG8_STAGE(PG8_SA(1, 0), a3, voffA);
            PG8_WAIT_V(8); PG8_WAIT_L(0); PG8_BAR; PG8_MMA(1, 0, At, B0); PG8_MMA(1, 1, At, B1); PG8_BAR; PG8_SCHED;
            } else {
            PG8_LDB(B0, 0, 0); PG8_SCHED; PG8_LDA(At, 0, 0); PG8_STAGE(PG8_SA(1, 1), a1 + hstep, voffA);
            PG8_WAIT_L(8); PG8_BAR; PG8_WAIT_L(0); PG8_MMA(0, 0, At, B0); PG8_BAR; PG8_SCHED;
            PG8_LDB(B1, 0, 1); PG8_STAGE(PG8_SB(0, 0), b2, voffB);
            PG8_BAR; PG8_WAIT_L(0); PG8_MMA(0, 1, At, B1); PG8_BAR;
            PG8_LDA(At, 0, 1); PG8_STAGE(PG8_SA(0, 0), a2, voffA);
            PG8_BAR; PG8_WAIT_L(0); PG8_MMA(1, 0, At, B0); PG8_BAR; PG8_SCHED;
            PG8_STAGE(PG8_SB(0, 1), b2 + hstep, voffB);
            PG8_WAIT_V(6); PG8_BAR; PG8_MMA(1, 1, At, B1); PG8_BAR;
            PG8_LDB(B0, 1, 0); PG8_SCHED; PG8_LDA(At, 1, 0); PG8_STAGE(PG8_SA(0, 1), a2 + hstep, voffA);
            PG8_WAIT_L(8); PG8_BAR; PG8_WAIT_L(0); PG8_MMA(0, 0, At, B0); PG8_BAR; PG8_SCHED;
            PG8_LDB(B1, 1, 1); PG8_STAGE(PG8_SB(1, 0), b3, voffB);
            PG8_BAR; PG8_WAIT_L(0); PG8_MMA(0, 1, At, B1); PG8_BAR;
            PG8_LDA(At, 1, 1); PG8_STAGE(PG8_SA(1, 0), a3, voffA);
            PG8_BAR; PG8_WAIT_L(0); PG8_MMA(1, 0, At, B0); PG8_BAR; PG8_SCHED;
            PG8_STAGE(PG8_SB(1, 1), b3 + hstep, voffB);
            PG8_WAIT_V(6); PG8_BAR; PG8_MMA(1, 1, At, B1); PG8_BAR;
            }
        }
        if constexpr (ALIGN_EPI) { if (wr == 0) PG8_BAR; }
        if constexpr (!Epi::AFTER_DRAIN) { E(acc, cur, wr, wc, fr, fq); S.done(cur); }
        if (!has_next) break;
#pragma unroll
        for (int a = 0; a < 2; ++a)
#pragma unroll
            for (int b = 0; b < 2; ++b)
#pragma unroll
                for (int m = 0; m < 4; ++m)
#pragma unroll
                    for (int n = 0; n < 2; ++n) acc[a][b][m][n] = (f32x4){0.f, 0.f, 0.f, 0.f};
        cur = nxt; cA = nA; cB = nB; ++ui;
        if constexpr (ALIGN_EPI) { if (wr == 1) PG8_BAR; }
    }
    PG8_WAIT_V(0);
    if constexpr (!ALIGN_EPI) { if (wr == 0) PG8_BAR; }
    PG8_BAR;
    if constexpr (Epi::AFTER_DRAIN) { E.fused(acc, cur, wr, wc, fr, fq, lds, wid, lane); S.done(cur); }
#undef PG8_SA
#undef PG8_SB
#undef PG8_STAGE
#undef PG8_LDA
#undef PG8_LDB
#undef PG8_MMA
#undef PG8_WAIT_V
#undef PG8_WAIT_L
#undef PG8_BAR
#undef PG8_SCHED
}
}
#ifndef REP_D1
#define REP_D1 1
#endif
#ifndef REP_D2
#define REP_D2 1
#endif
#ifndef REP_D3
#define REP_D3 1
#endif

#define LAS __attribute__((address_space(3)))
typedef unsigned short bf16;
typedef float f32x4 __attribute__((ext_vector_type(4)));
typedef unsigned u32x4 __attribute__((ext_vector_type(4)));
typedef short bf16x8 __attribute__((ext_vector_type(8)));

constexpr int DM = 1024, NBATCH = 8, SEQ = 2048, SB = 8, ST = 32, PAST = 1024, FF = 4096;
constexpr int MP = NBATCH * SEQ, MS = SB * ST, MT = MP + MS;
constexpr int EVEN_IN = 2560, ODD_SRC = 2628, ODD_IN = 2816;
constexpr int EQ = 0, EK = 512, EV = 1024, EU = 1536, EVB = 2048;
constexpr int OQ = 0, OK = 512, OV = 640, OQI = 768, OKI = 1024, OWI = 1088, OGB = 1152, OGC = 1664, OHD = 2176;
constexpr float EPS = 1e-6f;
constexpr size_t OFF_YP = 0, OFF_YS = OFF_YP + (size_t)MP * DM, OFF_AKP = OFF_YS + (size_t)MS * DM, OFF_AVP = OFF_AKP + (size_t)2 * MP * 512,
    OFF_AKS = OFF_AVP + (size_t)2 * MP * 512, OFF_AVS = OFF_AKS + (size_t)2 * MS * 512, OFF_BVS = OFF_AVS + (size_t)2 * MS * 512,
    OFF_CKP = OFF_BVS + (size_t)2 * MS * 512, OFF_CVP = OFF_CKP + (size_t)2 * MP * 128, OFF_CIP = OFF_CVP + (size_t)2 * MP * 128,
    OFF_CKS = OFF_CIP + (size_t)2 * MP * 64, OFF_CVS = OFF_CKS + (size_t)2 * MS * 128, OFF_CIS = OFF_CVS + (size_t)2 * MS * 128,
    OFF_DCP = OFF_CIS + (size_t)2 * MS * 64, OFF_DCS = OFF_DCP + (size_t)2 * 8 * 2 * 512, OUT_TOTAL = OFF_DCS + (size_t)2 * 8 * 2 * 512;
static_assert(OUT_TOTAL == 62062592, "output size");
constexpr size_t MiB = 1u << 20;
constexpr size_t WS_WINE = 0, WS_WINO = 10 * MiB, WS_WOUT = 21 * MiB, WS_W1 = 29 * MiB, WS_W2 = 61 * MiB, WS_H = 93 * MiB, WS_ACT = 126 * MiB,
    WS_Z = 126 * MiB, WS_CAT = 216 * MiB, WS_END = 256 * MiB,
    WS_VTP = 256 * MiB  , WS_KS = 261 * MiB  , WS_VTS = 264 * MiB  ,
    WS_KIS = 267 * MiB  , WS_VTA = 269 * MiB  , WS_KSA = 286 * MiB  ,
    WS_VTSA = 295 * MiB  , WS_CTL = 304 * MiB  , WS_END2 = 305 * MiB;
constexpr int VTL = 2112;
constexpr size_t CTL_BYTES = 16384;
constexpr size_t WS_WSB = WS_CTL + 65536;
constexpr int LDS_BARST = 143360;
constexpr int SKL = 1088;
static_assert(WS_WINE + (size_t)2 * EVEN_IN * DM * 2 <= WS_WINO && WS_WINO + (size_t)2 * ODD_IN * DM * 2 <= WS_WOUT && WS_H + (size_t)MT * DM * 2 <= WS_ACT &&
              WS_Z + (size_t)MT * ODD_IN * 2 <= WS_CAT && WS_CAT + (size_t)MT * DM * 2 <= WS_END && WS_ACT + (size_t)MT * FF * 2 <= WS_END, "ws map");
constexpr int LDS_BYTES = 147456;

struct Args { const float* in[24]; float* out; unsigned char* ws; int ph_lo, ph_hi; };
static_assert(sizeof(Args) == 216 && offsetof(Args, out) == 192 && offsetof(Args, ws) == 200, "Args layout (re-read from the kernarg segment by offset)");

__device__ __forceinline__ float bf2f(unsigned v) { return __uint_as_float(v << 16); }
__device__ __forceinline__ unsigned f2bf(float f) { unsigned u = __float_as_uint(f); return (u + 0x7fffu + ((u >> 16) & 1u)) >> 16; }
__device__ __forceinline__ unsigned pk2(float lo, float hi) { return f2bf(lo) | (f2bf(hi) << 16); }
__device__ __forceinline__ void unpack8(const u32x4 r, float (&f)[8]) {
    f[0] = __uint_as_float(r.x << 16); f[1] = __uint_as_float(r.x & 0xffff0000u); f[2] = __uint_as_float(r.y << 16); f[3] = __uint_as_float(r.y & 0xffff0000u);
    f[4] = __uint_as_float(r.z << 16); f[5] = __uint_as_float(r.z & 0xffff0000u); f[6] = __uint_as_float(r.w << 16); f[7] = __uint_as_float(r.w & 0xffff0000u); }
__device__ __forceinline__ u32x4 pack8(const float (&f)[8]) { u32x4 o; o.x = pk2(f[0], f[1]); o.y = pk2(f[2], f[3]); o.z = pk2(f[4], f[5]); o.w = pk2(f[6], f[7]); return o; }
__device__ __forceinline__ float wave_sum(float v) {
#pragma unroll
    for (int o = 1; o < 64; o <<= 1) v += __shfl_xor(v, o);
    return v; }
__device__ __forceinline__ float wave_max(float v) {
#pragma unroll
    for (int o = 1; o < 64; o <<= 1) v = fmaxf(v, __shfl_xor(v, o));
    return v; }
__device__ __forceinline__ int wave_sum_i(int v) {
#pragma unroll
    for (int o = 1; o < 64; o <<= 1) v += __shfl_xor(v, o);
    return v; }
__device__ __forceinline__ int wave_count(int c) {
    c += __builtin_amdgcn_update_dpp(0, c, 0x111, 0xf, 0xf, true);
    c += __builtin_amdgcn_update_dpp(0, c, 0x112, 0xf, 0xf, true);
    c += __builtin_amdgcn_update_dpp(0, c, 0x114, 0xf, 0xf, true);
    c += __builtin_amdgcn_update_dpp(0, c, 0x118, 0xf, 0xf, true);
    return __builtin_amdgcn_readlane(c, 15) + __builtin_amdgcn_readlane(c, 31) + __builtin_amdgcn_readlane(c, 47) + __builtin_amdgcn_readlane(c, 63);
}
#define LDS_WAIT() asm volatile("s_waitcnt lgkmcnt(0)" ::: "memory")
__device__ __forceinline__ float gelu_tanh(float x) {
    const float u2 = -1.5957691216057308f * (x + 0.044715f * x * x * x); return x * __builtin_amdgcn_rcpf(1.f + __expf(u2)); }

__device__ __forceinline__ void transpose_item(const float* W, int K, int Nsrc, bf16* WT, int nblk, int mode, LAS float* scr, int item, int lane) {
    const int kb = item / nblk, nb = item % nblk, k0 = 64 * kb, n0 = 32 * nb;
    const int nd = n0 + (lane & 31);
    int src = nd;
    if (mode == 1) src = nd < 1092 ? nd : (nd < 1152 ? -1 : (nd < 2688 ? nd - 60 : -1));
#pragma unroll 8
    for (int i = 0; i < 32; ++i) { const int kk = 2 * i + (lane >> 5); scr[kk * 33 + (lane & 31)] = (src >= 0) ? W[(size_t)(k0 + kk) * Nsrc + src] : 0.f; }
    LDS_WAIT();
    const int c = lane & 7;
#pragma unroll
    for (int jn = 0; jn < 4; ++jn) { const int n = (lane >> 3) + 8 * jn; const LAS float* s = scr + (8 * c) * 33 + n;
        u32x4 o; o.x = pk2(s[0 * 33], s[1 * 33]); o.y = pk2(s[2 * 33], s[3 * 33]); o.z = pk2(s[4 * 33], s[5 * 33]); o.w = pk2(s[6 * 33], s[7 * 33]);
        *(u32x4*)(WT + (size_t)(n0 + n) * K + k0 + 8 * c) = o; }
    LDS_WAIT();
}
__device__ __forceinline__ void norm_row(const float* xrow, const float* g, bf16* orow, float* xcopy, int lane) {
    const f32x4* xr = (const f32x4*)xrow + lane; f32x4 v[4]; float s = 0.f;
#pragma unroll
    for (int q = 0; q < 4; ++q) { v[q] = xr[64 * q]; s += (v[q].x * v[q].x + v[q].y * v[q].y) + (v[q].z * v[q].z + v[q].w * v[q].w); }
    const float r = rsqrtf(wave_sum(s) * (1.f / 1024.f) + EPS);
    const f32x4* gr = (const f32x4*)g + lane;
    unsigned long long* o8 = (unsigned long long*)orow + lane;
#pragma unroll
    for (int q = 0; q < 4; ++q) { const f32x4 gg = gr[64 * q]; const f32x4 y = v[q] * r * gg;
        o8[64 * q] = (unsigned long long)pk2(y.x, y.y) | ((unsigned long long)pk2(y.z, y.w) << 32);
        if (xcopy) ((f32x4*)xcopy)[lane + 64 * q] = v[q]; }
}
__device__ __forceinline__ void p_prologue(const Args& a, LAS unsigned char* lds, int gw, int NGW, int wave, int lane) {
    unsigned char* ws = a.ws;
    LAS float* scr = (LAS float*)(lds + wave * 16384);
    constexpr int I_E = 16 * 80, I_O = 16 * 88, I_W = 16 * 32, I_1 = 16 * 128, I_2 = 64 * 32;
    constexpr int NITEMS = 2 * I_E + 2 * I_O + 4 * I_W + 4 * I_1 + 4 * I_2;
    for (int it = gw; it < NITEMS; it += NGW) {
        int r = it;
        if (r < 2 * I_E) { const int j = r / I_E; transpose_item(a.in[10] + (size_t)j * DM * EVEN_IN, DM, EVEN_IN, (bf16*)(ws + WS_WINE) + (size_t)j * EVEN_IN * DM, 80, 0, scr, r % I_E, lane); continue; } r -= 2 * I_E;
        if (r < 2 * I_O) { const int j = r / I_O; transpose_item(a.in[17] + (size_t)j * DM * ODD_SRC, DM, ODD_SRC, (bf16*)(ws + WS_WINO) + (size_t)j * ODD_IN * DM, 88, 1, scr, r % I_O, lane); continue; } r -= 2 * I_O;
        if (r < 4 * I_W) { const int li = r / I_W; const float* src = ((li & 1) ? a.in[21] : a.in[16]) + (size_t)(li >> 1) * DM * DM;
            transpose_item(src, DM, DM, (bf16*)(ws + WS_WOUT) + (size_t)li * DM * DM, 32, 0, scr, r % I_W, lane); continue; } r -= 4 * I_W;
        if (r < 4 * I_1) { const int li = r / I_1; transpose_item(a.in[22] + (size_t)li * DM * FF, DM, FF, (bf16*)(ws + WS_W1) + (size_t)li * FF * DM, 128, 0, scr, r % I_1, lane); continue; } r -= 4 * I_1;
        { const int li = r / I_2; transpose_item(a.in[23] + (size_t)li * FF * DM, FF, DM, (bf16*)(ws + WS_W2) + (size_t)li * DM * FF, 32, 0, scr, r % I_2, lane); }
    }
    {
        bf16* wsb = (bf16*)(ws + WS_WSB);
        for (int e = gw * 64 + lane; e < 2 * 4 * 128 * 128; e += NGW * 64) { const int p = (e >> 7) & 127, q = e & 127; wsb[e] = (bf16)f2bf(((q >> 6) <= (p >> 6)) ? a.in[14][e] : 0.f); }
    }
    bf16* H = (bf16*)(ws + WS_H);
    for (int m = gw; m < MT; m += NGW) { const float* src = m < MP ? a.in[0] + (size_t)m * DM : a.in[1] + (size_t)(m - MP) * DM;
        norm_row(src, a.in[8], H + (size_t)m * DM, a.out + (size_t)m * DM, lane); }
}
__device__ __forceinline__ void norm_row2(const float* x0, const float* x1, const float* g, bf16* o0, bf16* o1, int lane) {
    const f32x4* xr0 = (const f32x4*)x0 + lane; const f32x4* xr1 = (const f32x4*)x1 + lane; f32x4 v0[4], v1[4]; float s0 = 0.f, s1 = 0.f;
#pragma unroll
    for (int q = 0; q < 4; ++q) { v0[q] = xr0[64 * q]; v1[q] = xr1[64 * q]; }
#pragma unroll
    for (int q = 0; q < 4; ++q) { s0 += (v0[q].x * v0[q].x + v0[q].y * v0[q].y) + (v0[q].z * v0[q].z + v0[q].w * v0[q].w); s1 += (v1[q].x * v1[q].x + v1[q].y * v1[q].y) + (v1[q].z * v1[q].z + v1[q].w * v1[q].w); }
#pragma unroll
    for (int o = 1; o < 64; o <<= 1) { s0 += __shfl_xor(s0, o); s1 += __shfl_xor(s1, o); }
    const float r0 = rsqrtf(s0 * (1.f / 1024.f) + EPS), r1 = rsqrtf(s1 * (1.f / 1024.f) + EPS);
    const f32x4* gr = (const f32x4*)g + lane;
    unsigned long long* p0 = (unsigned long long*)o0 + lane; unsigned long long* p1 = (unsigned long long*)o1 + lane;
#pragma unroll
    for (int q = 0; q < 4; ++q) { const f32x4 gg = gr[64 * q]; const f32x4 y0 = v0[q] * r0 * gg, y1 = v1[q] * r1 * gg;
        p0[64 * q] = (unsigned long long)pk2(y0.x, y0.y) | ((unsigned long long)pk2(y0.z, y0.w) << 32);
        p1[64 * q] = (unsigned long long)pk2(y1.x, y1.y) | ((unsigned long long)pk2(y1.z, y1.w) << 32); }
}
__device__ __forceinline__ void p_norm(const Args& a, const float* g, int gw, int NGW, int lane) {
    bf16* H = (bf16*)(a.ws + WS_H);
    for (int m = 2 * gw; m < MT; m += 2 * NGW) norm_row2(a.out + (size_t)m * DM, a.out + (size_t)(m + 1) * DM, g, H + (size_t)m * DM, H + (size_t)(m + 1) * DM, lane);
}

__device__ __forceinline__ void store8f(float* p, const float (&f)[8]) { *(f32x4*)p = (f32x4){f[0], f[1], f[2], f[3]}; *(f32x4*)(p + 4) = (f32x4){f[4], f[5], f[6], f[7]}; }
struct EvRaw { u32x4 q, k, v, u, vb; };
__device__ __forceinline__ EvRaw even_load(const bf16* z, int lane) { EvRaw r; r.q = *(const u32x4*)(z + EQ + 8 * lane); r.k = *(const u32x4*)(z + EK + 8 * lane); r.v = *(const u32x4*)(z + EV + 8 * lane);
    r.u = *(const u32x4*)(z + EU + 8 * lane); r.vb = *(const u32x4*)(z + EVB + 8 * lane); return r; }
__device__ __forceinline__ void even_post_row(const Args& a, int j, int r, int lane, LAS bf16* vtl, bool to_lds, const EvRaw& raw) {
    bf16* z = (bf16*)(a.ws + WS_Z) + (size_t)r * EVEN_IN;
    const bool samp = r >= MP; const int rs = r - MP;
    const int d0 = (8 * lane) & 63;
    const u32x4 raw_q = raw.q, raw_k = raw.k, raw_v = raw.v, raw_u = raw.u, raw_vb = raw.vb;
    float gq8[8], gk8[8], gb8[8];
    { const float* p = a.in[11] + j * 64 + d0; const float* q = a.in[12] + j * 64 + d0; const float* s = a.in[13] + j * 512 + 8 * lane;
#pragma unroll
      for (int e = 0; e < 8; ++e) { gq8[e] = p[e]; gk8[e] = q[e]; gb8[e] = s[e]; } }
    float f[8];
    {
        unpack8(raw_q, f);
        float ss = 0.f;
#pragma unroll
        for (int e = 0; e < 8; ++e) ss += f[e] * f[e];
        ss += __shfl_xor(ss, 1); ss += __shfl_xor(ss, 2); ss += __shfl_xor(ss, 4);
        const float rn = rsqrtf(ss * (1.f / 64.f) + EPS);
#pragma unroll
        for (int e = 0; e < 8; ++e) f[e] = f[e] * rn * gq8[e];
        *(u32x4*)(z + EQ + 8 * lane) = pack8(f);
    }
    {
        unpack8(raw_k, f);
        float ss = 0.f;
#pragma unroll
        for (int e = 0; e < 8; ++e) ss += f[e] * f[e];
        ss += __shfl_xor(ss, 1); ss += __shfl_xor(ss, 2); ss += __shfl_xor(ss, 4);
        const float rn = rsqrtf(ss * (1.f / 64.f) + EPS);
#pragma unroll
        for (int e = 0; e < 8; ++e) f[e] = f[e] * rn * gk8[e];
        *(u32x4*)(z + EK + 8 * lane) = pack8(f);
        if (samp) *(u32x4*)((bf16*)(a.ws + WS_KSA) + ((size_t)(rs / ST) * SKL + PAST + (rs % ST)) * 512 + 8 * lane) = pack8(f);
        float* o = samp ? a.out + OFF_AKS + (size_t)j * MS * 512 + (size_t)rs * 512 : a.out + OFF_AKP + (size_t)j * MP * 512 + (size_t)r * 512;
        store8f(o + 8 * lane, f);
    }
    {
        unpack8(raw_v, f);
        float* o = samp ? a.out + OFF_AVS + (size_t)j * MS * 512 + (size_t)rs * 512 : a.out + OFF_AVP + (size_t)j * MP * 512 + (size_t)r * 512;
        store8f(o + 8 * lane, f);
        if (to_lds) *(LAS u32x4*)(vtl + 8 * lane) = pack8(f);
        else {
            const int hh = lane >> 3;
            bf16* vt; size_t vs;
            if (samp) { vs = SKL; vt = (bf16*)(a.ws + WS_VTSA) + ((size_t)((rs / ST) * 8 + hh) * 64 + d0) * SKL + PAST + (rs % ST); }
            else { vs = VTL; vt = (bf16*)(a.ws + WS_VTA) + ((size_t)((r / SEQ) * 8 + hh) * 64 + d0) * VTL + (r % SEQ); }
#pragma unroll
            for (int e = 0; e < 8; ++e) vt[(size_t)e * vs] = (bf16)f2bf(f[e]);
        }
    }
    {
        unpack8(raw_u, f);
#pragma unroll
        for (int e = 0; e < 8; ++e) f[e] = gelu_tanh(f[e]);
        *(u32x4*)(z + EU + 8 * lane) = pack8(f);
    }
    {
        unpack8(raw_vb, f);
        float ss = 0.f;
#pragma unroll
        for (int e = 0; e < 8; ++e) { f[e] = gelu_tanh(f[e]); ss += f[e] * f[e]; }
        const float rn = rsqrtf(wave_sum(ss) * (1.f / 512.f) + EPS);
#pragma unroll
        for (int e = 0; e < 8; ++e) f[e] = f[e] * rn * gb8[e];
        *(u32x4*)(z + EVB + 8 * lane) = pack8(f);
        if (samp) store8f(a.out + OFF_BVS + (size_t)j * MS * 512 + (size_t)rs * 512 + 8 * lane, f);
    }
}
__device__ __forceinline__ void cin8(const bf16* zrow, int lane, float (&c)[8]) {
    float gc[8], hd[8]; unpack8(*(const u32x4*)(zrow + OGC + 8 * lane), gc); unpack8(*(const u32x4*)(zrow + OHD + 8 * lane), hd);
#pragma unroll
    for (int e = 0; e < 8; ++e) c[e] = gc[e] * hd[e];
}
struct OdRaw { u32x4 q, gb; unsigned k, v, ki; float c2[8], c1[8], c0[8]; };
__device__ __forceinline__ void odd_load(const Args& a, int j, int r, int lane, OdRaw& R) {
    const bf16* z = (const bf16*)(a.ws + WS_Z) + (size_t)r * ODD_IN;
    const bool samp = r >= MP; const int rs = r - MP;
    const int b = samp ? rs / ST : r / SEQ, t = samp ? rs % ST : r % SEQ;
    R.q = *(const u32x4*)(z + OQ + 8 * lane); R.gb = *(const u32x4*)(z + OGB + 8 * lane);
    R.k = *(const unsigned*)(z + OK + 2 * lane); R.v = *(const unsigned*)(z + OV + 2 * lane); R.ki = z[OKI + lane];
    cin8(z, lane, R.c2);
    const float* prev = a.in[7] + ((size_t)(j * 8 + b) * 2) * 512 + 8 * lane;
    if (t >= 1) cin8(z - ODD_IN, lane, R.c1);
    else {
#pragma unroll
        for (int e = 0; e < 8; ++e) R.c1[e] = samp ? prev[512 + e] : 0.f; }
    if (t >= 2) cin8(z - 2 * ODD_IN, lane, R.c0);
    else {
#pragma unroll
        for (int e = 0; e < 8; ++e) R.c0[e] = samp ? prev[t * 512 + e] : 0.f; }
}
__device__ __forceinline__ void odd_post_row(const Args& a, int j, int r, int lane, LAS bf16* vtl, bool to_lds, const OdRaw& R) {
    bf16* Zb = (bf16*)(a.ws + WS_Z);
    bf16* z = Zb + (size_t)r * ODD_IN;
    const bool samp = r >= MP; const int rs = r - MP;
    const int b = samp ? rs / ST : r / SEQ, t = samp ? rs % ST : r % SEQ, T = samp ? ST : SEQ;
    const u32x4 raw_q = R.q, raw_gb = R.gb; const unsigned raw_k = R.k, raw_v = R.v, raw_ki = R.ki;
    float c2[8], c1[8], c0[8];
#pragma unroll
    for (int e = 0; e < 8; ++e) { c2[e] = R.c2[e]; c1[e] = R.c1[e]; c0[e] = R.c0[e]; }
    float gq8[8], cw24[24]; float gk0, gk1;
    { const float* p = a.in[18] + j * 64 + ((8 * lane) & 63); const float* q = a.in[19] + j * 64 + ((2 * lane) & 63); const float* cwp = a.in[20] + (size_t)j * 3 * 512 + 8 * lane;
      gk0 = q[0]; gk1 = q[1];
#pragma unroll
      for (int e = 0; e < 8; ++e) { gq8[e] = p[e]; cw24[e] = cwp[e]; cw24[8 + e] = cwp[512 + e]; cw24[16 + e] = cwp[1024 + e]; } }
    float f[8];
    {
        unpack8(raw_q, f);
        float ss = 0.f;
#pragma unroll
        for (int e = 0; e < 8; ++e) ss += f[e] * f[e];
        ss += __shfl_xor(ss, 1); ss += __shfl_xor(ss, 2); ss += __shfl_xor(ss, 4);
        const float rn = rsqrtf(ss * (1.f / 64.f) + EPS);
#pragma unroll
        for (int e = 0; e < 8; ++e) f[e] = f[e] * rn * gq8[e];
        *(u32x4*)(z + OQ + 8 * lane) = pack8(f);
    }
    {
        const unsigned raw = raw_k;
        float k0 = __uint_as_float(raw << 16), k1 = __uint_as_float(raw & 0xffff0000u);
        float ss = k0 * k0 + k1 * k1;
        ss += __shfl_xor(ss, 1); ss += __shfl_xor(ss, 2); ss += __shfl_xor(ss, 4); ss += __shfl_xor(ss, 8); ss += __shfl_xor(ss, 16);
        const float rn = rsqrtf(ss * (1.f / 64.f) + EPS);
        k0 = k0 * rn * gk0; k1 = k1 * rn * gk1;
        *(unsigned*)(z + OK + 2 * lane) = pk2(k0, k1);
        if (samp) *(unsigned*)((bf16*)(a.ws + WS_KS) + ((size_t)b * SKL + PAST + t) * 128 + 2 * lane) = pk2(k0, k1);
        float* o = samp ? a.out + OFF_CKS + (size_t)j * MS * 128 + (size_t)rs * 128 : a.out + OFF_CKP + (size_t)j * MP * 128 + (size_t)r * 128;
        o[2 * lane] = k0; o[2 * lane + 1] = k1;
    }
    {
        const unsigned raw = raw_v;
        float* o = samp ? a.out + OFF_CVS + (size_t)j * MS * 128 + (size_t)rs * 128 : a.out + OFF_CVP + (size_t)j * MP * 128 + (size_t)r * 128;
        o[2 * lane] = __uint_as_float(raw << 16); o[2 * lane + 1] = __uint_as_float(raw & 0xffff0000u);
        const int gg = lane >> 5, dd = (2 * lane) & 63;
        if (to_lds) *(LAS unsigned*)(vtl + 2 * lane) = raw;
        else if (samp) { bf16* vt = (bf16*)(a.ws + WS_VTS) + ((size_t)(b * 2 + gg) * 64 + dd) * SKL + PAST + t; vt[0] = (bf16)(raw & 0xffffu); vt[SKL] = (bf16)(raw >> 16); }
        else { bf16* vt = (bf16*)(a.ws + WS_VTP) + ((size_t)(b * 2 + gg) * 64 + dd) * VTL + t; vt[0] = (bf16)(raw & 0xffffu); vt[VTL] = (bf16)(raw >> 16); }
    }
    {
        float* o = samp ? a.out + OFF_CIS + (size_t)j * MS * 64 + (size_t)rs * 64 : a.out + OFF_CIP + (size_t)j * MP * 64 + (size_t)r * 64;
        o[lane] = bf2f(raw_ki);
        if (samp) ((bf16*)(a.ws + WS_KIS))[((size_t)b * SKL + PAST + t) * 64 + lane] = (bf16)raw_ki;
    }
    {
        float gb[8];
        unpack8(raw_gb, gb);
#pragma unroll
        for (int e = 0; e < 8; ++e) f[e] = gb[e] * (cw24[e] * c0[e] + cw24[8 + e] * c1[e] + cw24[16 + e] * c2[e]);
        *(u32x4*)((bf16*)(a.ws + WS_CAT) + (size_t)r * DM + 512 + 8 * lane) = pack8(f);
        if (t >= T - 2) { const int slot = t - (T - 2);
            float* o = (samp ? a.out + OFF_DCS : a.out + OFF_DCP) + ((size_t)(j * 8 + b) * 2 + slot) * 512 + 8 * lane;
            store8f(o, c2); }
    }
}

__device__ __forceinline__ void sb_item(const Args& a, int j, int item, LAS unsigned char* lds, int tid, int w, int lane) {
    int b, h, zq_row0, nq, qpos0, P, zk_row0, kend;
    if (item < 2048) { b = item >> 8; h = (item >> 5) & 7; const int qt = item & 31; zq_row0 = b * SEQ + qt * 64; nq = 64; qpos0 = qt * 64; P = 0; zk_row0 = b * SEQ; kend = qpos0 + 64; }
    else { const int s = item - 2048; b = s >> 3; h = s & 7; zq_row0 = MP + b * ST; nq = ST; qpos0 = PAST; P = PAST; zk_row0 = MP + b * ST; kend = PAST + ST; }
    const bf16* Z = (const bf16*)(a.ws + WS_Z);
    LAS float* Qs = (LAS float*)lds;
    LAS float* Ks = Qs + 64 * 68;
    LAS float* Vs = Ks + 64 * 68;
    LAS float* Wm = Vs + 64 * 64;
    LAS int* flags = (LAS int*)(Wm + 64 * 64);
    __syncthreads();
    {
        const int qi = tid >> 3, dd = (tid & 7) * 8; float f[8];
        if (qi < nq) { unpack8(*(const u32x4*)(Z + (size_t)(zq_row0 + qi) * EVEN_IN + EQ + h * 64 + dd), f);
#pragma unroll
            for (int e = 0; e < 8; ++e) f[e] *= 0.125f; }
        else {
#pragma unroll
            for (int e = 0; e < 8; ++e) f[e] = 0.f; }
        *(LAS f32x4*)(Qs + qi * 68 + dd) = (f32x4){f[0], f[1], f[2], f[3]}; *(LAS f32x4*)(Qs + qi * 68 + dd + 4) = (f32x4){f[4], f[5], f[6], f[7]};
    }
    float carry[8], o[8];
#pragma unroll
    for (int i = 0; i < 8; ++i) { carry[i] = 0.f; o[i] = 0.f; }
    const int kt_hi = (kend - 1) >> 6;
    const float* cak = a.in[2]; const float* cav = a.in[3];
    for (int kt = kt_hi; kt >= 0; --kt) {
        __syncthreads();
        if (kt != kt_hi) { int all = 1;
#pragma unroll
            for (int x = 0; x < 8; ++x) all &= flags[x];
            if (all) break; }
        {
            const int key = tid >> 3, dd = (tid & 7) * 8, p = kt * 64 + key; float kf[8], vf[8];
            if (p < P) { const size_t off = (((size_t)(j * 8 + b) * PAST + p) * 8 + h) * 64 + dd;
                const f32x4 k0 = *(const f32x4*)(cak + off), k1 = *(const f32x4*)(cak + off + 4), v0 = *(const f32x4*)(cav + off), v1 = *(const f32x4*)(cav + off + 4);
                kf[0] = k0.x; kf[1] = k0.y; kf[2] = k0.z; kf[3] = k0.w; kf[4] = k1.x; kf[5] = k1.y; kf[6] = k1.z; kf[7] = k1.w;
                vf[0] = v0.x; vf[1] = v0.y; vf[2] = v0.z; vf[3] = v0.w; vf[4] = v1.x; vf[5] = v1.y; vf[6] = v1.z; vf[7] = v1.w; }
            else if (p < kend) { const bf16* zr = Z + (size_t)(zk_row0 + p - P) * EVEN_IN + h * 64 + dd;
                unpack8(*(const u32x4*)(zr + EK), kf); unpack8(*(const u32x4*)(zr + EV), vf); }
            else {
#pragma unroll
                for (int e = 0; e < 8; ++e) { kf[e] = 0.f; vf[e] = 0.f; } }
            *(LAS f32x4*)(Ks + key * 68 + dd) = (f32x4){kf[0], kf[1], kf[2], kf[3]}; *(LAS f32x4*)(Ks + key * 68 + dd + 4) = (f32x4){kf[4], kf[5], kf[6], kf[7]};
            *(LAS f32x4*)(Vs + key * 64 + dd) = (f32x4){vf[0], vf[1], vf[2], vf[3]}; *(LAS f32x4*)(Vs + key * 64 + dd + 4) = (f32x4){vf[4], vf[5], vf[6], vf[7]};
        }
        __syncthreads();
        float zz[8];
#pragma unroll
        for (int i = 0; i < 8; ++i) zz[i] = 0.f;
#pragma unroll 4
        for (int dq = 0; dq < 16; ++dq) { const f32x4 kv = *(const LAS f32x4*)(Ks + lane * 68 + 4 * dq);
#pragma unroll
            for (int i = 0; i < 8; ++i) { const f32x4 qv = *(const LAS f32x4*)(Qs + (w * 8 + i) * 68 + 4 * dq); zz[i] += (qv.x * kv.x + qv.y * kv.y) + (qv.z * kv.z + qv.w * kv.w); } }
        const int s = kt * 64 + lane;
#pragma unroll
        for (int i = 0; i < 8; ++i) {
            const int t = qpos0 + w * 8 + i; const bool valid = s < t; const float zv = zz[i];
            const float sp = fmaxf(zv, 0.f) + log1pf(expf(-fabsf(zv)));
            const float ls = valid ? -sp : 0.f;
            float v = ls;
#pragma unroll
            for (int off = 1; off < 64; off <<= 1) { const float t2 = __shfl_down(v, off); if (lane + off < 64) v += t2; }
            const float after = carry[i] + (v - ls);
            carry[i] += __shfl(v, 0);
            const float wgt = valid ? expf((zv - sp) + after) : 0.f;
            Wm[(w * 8 + i) * 64 + lane] = wgt;
        }
        LDS_WAIT();
#pragma unroll 2
        for (int s4 = 0; s4 < 16; ++s4) {
            const float v0 = Vs[(4 * s4 + 0) * 64 + lane], v1 = Vs[(4 * s4 + 1) * 64 + lane], v2 = Vs[(4 * s4 + 2) * 64 + lane], v3 = Vs[(4 * s4 + 3) * 64 + lane];
#pragma unroll
            for (int i = 0; i < 8; ++i) { const f32x4 wv = *(const LAS f32x4*)(Wm + (w * 8 + i) * 64 + 4 * s4); o[i] += (wv.x * v0 + wv.y * v1) + (wv.z * v2 + wv.w * v3); } }
        float mx = -1e30f;
#pragma unroll
        for (int i = 0; i < 8; ++i) if (w * 8 + i < nq) mx = fmaxf(mx, carry[i]);
        if (lane == 0) flags[w] = (mx < -110.f) ? 1 : 0;
    }
    bf16* CAT = (bf16*)(a.ws + WS_CAT);
#pragma unroll
    for (int i = 0; i < 8; ++i) { const int qi = w * 8 + i; if (qi < nq) CAT[(size_t)(zq_row0 + qi) * DM + h * 64 + lane] = (bf16)f2bf(o[i]); }
}
__device__ __forceinline__ void cache_a_row(const Args& a, int j, int bp, int lane, LAS bf16* vtl) {
    const int b = bp >> 10, p = bp & 1023;
    const float* ck = a.in[2] + ((size_t)(j * 8 + b) * PAST + p) * 512 + 8 * lane; const float* cv = a.in[3] + ((size_t)(j * 8 + b) * PAST + p) * 512 + 8 * lane;
    const f32x4 k0 = *(const f32x4*)ck, k1 = *(const f32x4*)(ck + 4), v0 = *(const f32x4*)cv, v1 = *(const f32x4*)(cv + 4);
    u32x4 pk; pk.x = pk2(k0.x, k0.y); pk.y = pk2(k0.z, k0.w); pk.z = pk2(k1.x, k1.y); pk.w = pk2(k1.z, k1.w);
    *(u32x4*)((bf16*)(a.ws + WS_KSA) + ((size_t)b * SKL + p) * 512 + 8 * lane) = pk;
    u32x4 pv; pv.x = pk2(v0.x, v0.y); pv.y = pk2(v0.z, v0.w); pv.z = pk2(v1.x, v1.y); pv.w = pk2(v1.z, v1.w);
    *(LAS u32x4*)(vtl + 8 * lane) = pv;
}
struct SbSrc { const bf16* kb; int ks; const bf16* vt; int vts; };
__device__ __forceinline__ void sb2_tile(const f32x4 z, int base, int t, int quad, float& carry, float (&wout)[4]) {
    float ls[4], lz[4]; bool valid[4];
#pragma unroll
    for (int jj = 0; jj < 4; ++jj) { const int key = base + quad * 4 + jj; valid[jj] = (key < t) && (key >= 0);
        const float zv = z[jj] * 0.125f; const float sp = fmaxf(zv, 0.f) + __logf(1.f + __expf(-fabsf(zv)));
        ls[jj] = valid[jj] ? -sp : 0.f; lz[jj] = zv - sp; }
    const float e3 = 0.f, e2 = ls[3], e1 = e2 + ls[2], e0 = e1 + ls[1], T = e0 + ls[0];
    const float t1 = __shfl_xor(T, 16), t2 = __shfl_xor(T, 32), t3 = __shfl_xor(T, 48);
    const float H = (((quad ^ 1) > quad) ? t1 : 0.f) + (((quad ^ 2) > quad) ? t2 : 0.f) + (((quad ^ 3) > quad) ? t3 : 0.f);
    const float ba = carry + H;
    wout[0] = valid[0] ? __expf(lz[0] + ba + e0) : 0.f; wout[1] = valid[1] ? __expf(lz[1] + ba + e1) : 0.f;
    wout[2] = valid[2] ? __expf(lz[2] + ba + e2) : 0.f; wout[3] = valid[3] ? __expf(lz[3] + ba + e3) : 0.f;
    carry += (T + t1) + (t2 + t3);
}
__device__ __forceinline__ void sb2_wave_item(const Args& a, const SbSrc src, int zq_row0, int hcol, int qpos0, int lane) {
    const bf16* Z = (const bf16*)(a.ws + WS_Z);
    const int n = lane & 15, quad = lane >> 4;
    const bf16* zr = Z + (size_t)(zq_row0 + n) * EVEN_IN + EQ + hcol + quad * 8;
    const bf16x8 bq0 = *(const bf16x8*)zr, bq1 = *(const bf16x8*)(zr + 32);
    const int t = qpos0 + n;
    float carry = 0.f;
    f32x4 oacc[4];
#pragma unroll
    for (int mt = 0; mt < 4; ++mt) oacc[mt] = (f32x4){0.f, 0.f, 0.f, 0.f};
    const bf16* vbase = src.vt + (size_t)n * src.vts + quad * 4;
    const bf16* kbase = src.kb + (size_t)n * src.ks + quad * 8;
    bf16x8 ak[4]; unsigned long long vv[8];
#define SB_LOAD(AK, VV, ub_) do { const int lbc_ = (ub_) - 16 < 0 ? 0 : (ub_) - 16; const bf16* kup = kbase + (size_t)(ub_) * src.ks; const bf16* klp = kbase + (size_t)lbc_ * src.ks; \
        AK[0] = *(const bf16x8*)kup; AK[1] = *(const bf16x8*)(kup + 32); AK[2] = *(const bf16x8*)klp; AK[3] = *(const bf16x8*)(klp + 32); \
        _Pragma("unroll") for (int mt = 0; mt < 4; ++mt) { const bf16* vp = vbase + (size_t)(16 * mt) * src.vts; VV[2 * mt] = *(const unsigned long long*)(vp + lbc_); VV[2 * mt + 1] = *(const unsigned long long*)(vp + (ub_)); } } while (0)
    SB_LOAD(ak, vv, qpos0);
#pragma unroll 1
    for (int ub = qpos0; ub >= 0; ub -= 32) {
        const int lb = ub - 16;
        bf16x8 akn[4]; unsigned long long vvn[8];
        { const int ubn = ub >= 32 ? ub - 32 : 0; SB_LOAD(akn, vvn, ubn); }
        f32x4 zu = (f32x4){0.f, 0.f, 0.f, 0.f}, zl = (f32x4){0.f, 0.f, 0.f, 0.f};
        zu = __builtin_amdgcn_mfma_f32_16x16x32_bf16(ak[0], bq0, zu, 0, 0, 0); zu = __builtin_amdgcn_mfma_f32_16x16x32_bf16(ak[1], bq1, zu, 0, 0, 0);
        zl = __builtin_amdgcn_mfma_f32_16x16x32_bf16(ak[2], bq0, zl, 0, 0, 0); zl = __builtin_amdgcn_mfma_f32_16x16x32_bf16(ak[3], bq1, zl, 0, 0, 0);
        float wu[4], wl[4];
        sb2_tile(zu, ub, t, quad, carry, wu);
        sb2_tile(zl, lb, t, quad, carry, wl);
        u32x4 pk; pk.x = pg8::cvt_pk_bf16(wl[0], wl[1]); pk.y = pg8::cvt_pk_bf16(wl[2], wl[3]); pk.z = pg8::cvt_pk_bf16(wu[0], wu[1]); pk.w = pg8::cvt_pk_bf16(wu[2], wu[3]);
        const bf16x8 pb = __builtin_bit_cast(bf16x8, pk);
#pragma unroll
        for (int mt = 0; mt < 4; ++mt) { const unsigned long long lo = vv[2 * mt], hi = vv[2 * mt + 1];
            u32x4 vk; vk.x = (unsigned)lo; vk.y = (unsigned)(lo >> 32); vk.z = (unsigned)hi; vk.w = (unsigned)(hi >> 32);
            oacc[mt] = __builtin_amdgcn_mfma_f32_16x16x32_bf16(__builtin_bit_cast(bf16x8, vk), pb, oacc[mt], 0, 0, 0); }
        if (__all(carry < -110.f)) break;
#pragma unroll
        for (int x = 0; x < 4; ++x) ak[x] = akn[x];
#pragma unroll
        for (int x = 0; x < 8; ++x) vv[x] = vvn[x];
    }
#undef SB_LOAD
    bf16* orow = (bf16*)(a.ws + WS_CAT) + (size_t)(zq_row0 + n) * DM + hcol + quad * 4;
#pragma unroll
    for (int mt = 0; mt < 4; ++mt) *(unsigned long long*)(orow + 16 * mt) = (unsigned long long)pk2(oacc[mt].x, oacc[mt].y) | ((unsigned long long)pk2(oacc[mt].z, oacc[mt].w) << 32);
}
__device__ __forceinline__ void gate_item(const Args& a, int j, int item, LAS unsigned char* lds, int tid) {
    int b, g, P, row0;
    if (item < 512) { b = item >> 6; const int n = (item >> 2) & 15; g = item & 3; P = 128; row0 = b * SEQ + n * 128; }
    else { const int s = item - 512; b = s >> 2; g = s & 3; P = ST; row0 = MP + b * ST; }
    bf16* Z = (bf16*)(a.ws + WS_Z);
    LAS float* Wt = (LAS float*)lds;
    LAS float* VB = Wt + 128 * 128;
    __syncthreads();
    const float* wsb = a.in[14] + (size_t)(j * 4 + g) * 128 * 128;
    for (int e = tid; e < 128 * 32; e += 512) { const int p = e >> 5, q4 = (e & 31) * 4; const f32x4 wv = *(const f32x4*)(wsb + p * 128 + q4);
#pragma unroll
        for (int k = 0; k < 4; ++k) { const int q = q4 + k; Wt[q * 128 + p] = ((q >> 6) <= (p >> 6)) ? wv[k] : 0.f; } }
    for (int e = tid; e < 128 * 16; e += 512) { const int q = e >> 4, c8 = (e & 15) * 8;
        if (q < P) { float f[8]; unpack8(*(const u32x4*)(Z + (size_t)(row0 + q) * EVEN_IN + EVB + g * 128 + c8), f);
            *(LAS f32x4*)(VB + q * 128 + c8) = (f32x4){f[0], f[1], f[2], f[3]}; *(LAS f32x4*)(VB + q * 128 + c8 + 4) = (f32x4){f[4], f[5], f[6], f[7]}; } }
    __syncthreads();
    const int p0 = (tid >> 4) * 4, c0 = (tid & 15) * 8;
    if (p0 < P) {
        float acc[4][8];
#pragma unroll
        for (int x = 0; x < 4; ++x)
#pragma unroll
            for (int y = 0; y < 8; ++y) acc[x][y] = 0.f;
#pragma unroll 4
        for (int q = 0; q < P; ++q) { const f32x4 wv = *(const LAS f32x4*)(Wt + q * 128 + p0), v0 = *(const LAS f32x4*)(VB + q * 128 + c0), v1 = *(const LAS f32x4*)(VB + q * 128 + c0 + 4);
#pragma unroll
            for (int x = 0; x < 4; ++x) { acc[x][0] += wv[x] * v0.x; acc[x][1] += wv[x] * v0.y; acc[x][2] += wv[x] * v0.z; acc[x][3] += wv[x] * v0.w;
                acc[x][4] += wv[x] * v1.x; acc[x][5] += wv[x] * v1.y; acc[x][6] += wv[x] * v1.z; acc[x][7] += wv[x] * v1.w; } }
        bf16* CAT = (bf16*)(a.ws + WS_CAT);
#pragma unroll
        for (int x = 0; x < 4; ++x) { const int p = p0 + x; const float bias = a.in[15][(j * 4 + g) * 128 + p]; const size_t row = (size_t)(row0 + p);
            float u[8], f[8]; unpack8(*(const u32x4*)(Z + row * EVEN_IN + EU + g * 128 + c0), u);
#pragma unroll
            for (int y = 0; y < 8; ++y) f[y] = u[y] * (acc[x][y] + bias);
            *(u32x4*)(CAT + row * DM + 512 + g * 128 + c0) = pack8(f); }
    }
}
__device__ __forceinline__ void cache_c_row(const Args& a, int j, int bp, int lane, LAS bf16* vtl) {
    const int b = bp >> 10, p = bp & 1023;
    const float* ck = a.in[4] + ((size_t)(j * 8 + b) * PAST + p) * 128; const float* cv = a.in[5] + ((size_t)(j * 8 + b) * PAST + p) * 128;
    const float* ci = a.in[6] + ((size_t)(j * 8 + b) * PAST + p) * 64;
    *(unsigned*)((bf16*)(a.ws + WS_KS) + ((size_t)b * SKL + p) * 128 + 2 * lane) = pk2(ck[2 * lane], ck[2 * lane + 1]);
    *(LAS unsigned*)(vtl + 2 * lane) = pk2(cv[2 * lane], cv[2 * lane + 1]);
    ((bf16*)(a.ws + WS_KIS))[((size_t)b * SKL + p) * 64 + lane] = (bf16)f2bf(ci[lane]);
}
template <int NR> __device__ __forceinline__ void dsa_select(const LAS float* Srow, int L, int lane2, LAS unsigned long long* bmk) {
    unsigned u[NR];
#pragma unroll
    for (int i = 0; i < NR; ++i) { const int key = lane2 + 64 * i; unsigned x = 0u;
        if (key < L) { const unsigned bits = __float_as_uint(Srow[key]); x = (bits & 0x80000000u) ? ~bits : (bits | 0x80000000u); }
        u[i] = x; }
    unsigned thr = 0u; int need = 0;
    if (L > 256) {
        bool exact = false;
        for (int bit = 31; bit >= 0; --bit) { const unsigned cand = thr | (1u << bit); int c = 0;
#pragma unroll
            for (int i = 0; i < NR; ++i) c += (u[i] >= cand) ? 1 : 0;
            c = wave_count(c);
            if (c >= 256) thr = cand;
            if (c == 256) { exact = true; break; } }
        if (exact) { thr -= 1u; need = 0; }
        else { int cgt = 0;
#pragma unroll
            for (int i = 0; i < NR; ++i) cgt += (u[i] > thr) ? 1 : 0;
            need = 256 - wave_count(cgt); }
    }
    const unsigned long long lt = (1ull << lane2) - 1ull;
    int tie_seen = 0;
#pragma unroll
    for (int i = 0; i < NR; ++i) {
        const bool gt = u[i] > thr, eq = (u[i] == thr) && (need > 0);
        const unsigned long long beq = __ballot(eq); const int rank = tie_seen + __popcll(beq & lt); tie_seen += __popcll(beq);
        const bool sel = gt || (eq && rank < need);
        const unsigned long long bs = __ballot(sel);
        if (lane2 == 0) bmk[i] = bs; }
}
struct DsaSrc { const bf16* kb; int ks; const bf16* kib; int kis; const bf16* vt; int vts; };
__device__ __forceinline__ void dsa2_item(const Args& a, const DsaSrc src, int zq_row0, int L, LAS unsigned char* lds, int w, int lane) {
    const bf16* Z = (const bf16*)(a.ws + WS_Z);
    constexpr int SSTR = 2048;
    LAS float* S = (LAS float*)lds;
    LAS unsigned long long* BMK = (LAS unsigned long long*)(lds + 131072);
    const int n = lane & 15, quad = lane >> 4, hn = n & 3;
#pragma unroll 1
    for (int r = 0; r < 2; ++r) {
        __syncthreads();
        {
            bf16x8 bq[4][2]; float wsc[4];
#pragma unroll
            for (int nt = 0; nt < 4; ++nt) { const bf16* zr = Z + (size_t)(zq_row0 + r * 16 + nt * 4 + (n >> 2)) * ODD_IN;
#pragma unroll
                for (int kk = 0; kk < 2; ++kk) bq[nt][kk] = *(const bf16x8*)(zr + OQI + hn * 64 + kk * 32 + quad * 8);
                wsc[nt] = bf2f(zr[OWI + hn]) * 0.0625f; }
            const int ntile = L >> 4;
            bf16x8 af0, af1;
            if (w < ntile) { const bf16* kr = src.kib + (size_t)(w * 16 + n) * src.kis + quad * 8; af0 = *(const bf16x8*)kr; af1 = *(const bf16x8*)(kr + 32); }
            for (int kt = w; kt < ntile; kt += 8) {
                const int ktn = (kt + 8 < ntile) ? kt + 8 : kt;
                const bf16* krn = src.kib + (size_t)(ktn * 16 + n) * src.kis + quad * 8;
                const bf16x8 an0 = *(const bf16x8*)krn, an1 = *(const bf16x8*)(krn + 32);
#pragma unroll
                for (int nt = 0; nt < 4; ++nt) { f32x4 acc = (f32x4){0.f, 0.f, 0.f, 0.f};
                    acc = __builtin_amdgcn_mfma_f32_16x16x32_bf16(af0, bq[nt][0], acc, 0, 0, 0);
                    acc = __builtin_amdgcn_mfma_f32_16x16x32_bf16(af1, bq[nt][1], acc, 0, 0, 0);
#pragma unroll
                    for (int jj = 0; jj < 4; ++jj) { float v = fmaxf(acc[jj], 0.f) * wsc[nt]; v += __shfl_xor(v, 1); v += __shfl_xor(v, 2); acc[jj] = v; }
                    if (hn == 0) *(LAS f32x4*)(S + (nt * 4 + (n >> 2)) * SSTR + kt * 16 + quad * 4) = acc; }
                af0 = an0; af1 = an1;
            }
        }
        __syncthreads();
        int lane2 = lane; asm volatile("" : "+v"(lane2));
#pragma unroll 1
        for (int qq = 0; qq < 2; ++qq) { const int ql = 2 * w + qq;
            if (L <= 512) dsa_select<8>(S + ql * SSTR, L, lane2, BMK + (r * 16 + ql) * 32);
            else if (L <= 1024) dsa_select<16>(S + ql * SSTR, L, lane2, BMK + (r * 16 + ql) * 32);
            else if (L <= 1536) dsa_select<24>(S + ql * SSTR, L, lane2, BMK + (r * 16 + ql) * 32);
            else dsa_select<32>(S + ql * SSTR, L, lane2, BMK + (r * 16 + ql) * 32);
        }
    }
    __syncthreads();
    for (int rep3_ = 0; rep3_ < REP_D3; ++rep3_)
    {
        int lane3 = lane; asm volatile("" : "+v"(lane3));
        const int n = lane3 & 15, quad = lane3 >> 4, hn = n & 3, lane_r = lane3;
        const int g = w >> 2, qh = (w >> 1) & 1, kh = w & 1;
        bf16x8 bqk[4][2];
#pragma unroll
        for (int nt = 0; nt < 4; ++nt) { const bf16* zr = Z + (size_t)(zq_row0 + 16 * qh + 4 * nt + (n >> 2)) * ODD_IN + OQ + (4 * g + hn) * 64 + quad * 8;
            bqk[nt][0] = *(const bf16x8*)zr; bqk[nt][1] = *(const bf16x8*)(zr + 32); }
        f32x4 oacc[4][4]; float lsum[4];
#pragma unroll
        for (int nt = 0; nt < 4; ++nt) { lsum[nt] = 0.f;
#pragma unroll
            for (int mt = 0; mt < 4; ++mt) oacc[mt][nt] = (f32x4){0.f, 0.f, 0.f, 0.f}; }
        const int n32 = L >> 5, smid = (n32 + 1) >> 1, s_begin = kh ? smid : 0, s_end = kh ? n32 : smid;
        const bf16* kbase = src.kb + (size_t)n * src.ks + g * 64 + quad * 8;
        const bf16* vbase = src.vt + (size_t)(g * 64 + n) * src.vts + quad * 4;
        bf16x8 ak[4];
#define DSA_LOADK(AK, s_) do { const bf16* k0p = kbase + (size_t)((s_) * 32) * src.ks; const bf16* k1p = k0p + (size_t)16 * src.ks; \
            AK[0] = *(const bf16x8*)k0p; AK[1] = *(const bf16x8*)(k0p + 32); AK[2] = *(const bf16x8*)k1p; AK[3] = *(const bf16x8*)(k1p + 32); } while (0)
        if (s_begin < s_end) DSA_LOADK(ak, s_begin);
#pragma unroll 1
        for (int s = s_begin; s < s_end; ++s) {
            unsigned long long vv[8];
#pragma unroll
            for (int mt = 0; mt < 4; ++mt) { const bf16* vp = vbase + (size_t)(16 * mt) * src.vts + s * 32; vv[2 * mt] = *(const unsigned long long*)vp; vv[2 * mt + 1] = *(const unsigned long long*)(vp + 16); }
            bf16x8 akn[4];
            { const int sn = (s + 1 < s_end) ? s + 1 : s; DSA_LOADK(akn, sn); }
            bf16x8 av[4];
#pragma unroll
            for (int mt = 0; mt < 4; ++mt) { u32x4 pk; pk.x = (unsigned)vv[2 * mt]; pk.y = (unsigned)(vv[2 * mt] >> 32); pk.z = (unsigned)vv[2 * mt + 1]; pk.w = (unsigned)(vv[2 * mt + 1] >> 32); av[mt] = __builtin_bit_cast(bf16x8, pk); }
#pragma unroll
            for (int nt = 0; nt < 4; ++nt) {
                f32x4 s0 = (f32x4){0.f, 0.f, 0.f, 0.f}, s1 = (f32x4){0.f, 0.f, 0.f, 0.f};
                s0 = __builtin_amdgcn_mfma_f32_16x16x32_bf16(ak[0], bqk[nt][0], s0, 0, 0, 0); s0 = __builtin_amdgcn_mfma_f32_16x16x32_bf16(ak[1], bqk[nt][1], s0, 0, 0, 0);
                s1 = __builtin_amdgcn_mfma_f32_16x16x32_bf16(ak[2], bqk[nt][0], s1, 0, 0, 0); s1 = __builtin_amdgcn_mfma_f32_16x16x32_bf16(ak[3], bqk[nt][1], s1, 0, 0, 0);
                const unsigned long long word = BMK[(16 * qh + 4 * nt + (n >> 2)) * 32 + (s >> 1)];
                const unsigned half = (unsigned)(word >> ((s & 1) * 32));
                const unsigned b0 = (half >> (quad * 4)) & 0xFu, b1 = (half >> (16 + quad * 4)) & 0xFu;
                float p0[4], p1[4];
#pragma unroll
                for (int jj = 0; jj < 4; ++jj) {
                    p0[jj] = ((b0 >> jj) & 1u) ? __builtin_amdgcn_exp2f(fminf(s0[jj] * 0.18033688f, 86.f)) : 0.f;
                    p1[jj] = ((b1 >> jj) & 1u) ? __builtin_amdgcn_exp2f(fminf(s1[jj] * 0.18033688f, 86.f)) : 0.f; }
                lsum[nt] += ((p0[0] + p0[1]) + (p0[2] + p0[3])) + ((p1[0] + p1[1]) + (p1[2] + p1[3]));
                u32x4 pk; pk.x = pg8::cvt_pk_bf16(p0[0], p0[1]); pk.y = pg8::cvt_pk_bf16(p0[2], p0[3]); pk.z = pg8::cvt_pk_bf16(p1[0], p1[1]); pk.w = pg8::cvt_pk_bf16(p1[2], p1[3]);
                const bf16x8 pb = __builtin_bit_cast(bf16x8, pk);
#pragma unroll
                for (int mt = 0; mt < 4; ++mt) oacc[mt][nt] = __builtin_amdgcn_mfma_f32_16x16x32_bf16(av[mt], pb, oacc[mt][nt], 0, 0, 0);
            }
#pragma unroll
            for (int x = 0; x < 4; ++x) ak[x] = akn[x];
        }
#undef DSA_LOADK
        LAS float* RED = (LAS float*)lds + (size_t)(w >> 1) * (68 * 64);
        if (kh == 1) {
#pragma unroll
            for (int mt = 0; mt < 4; ++mt)
#pragma unroll
                for (int nt = 0; nt < 4; ++nt)
#pragma unroll
                    for (int e = 0; e < 4; ++e) RED[((mt * 4 + nt) * 4 + e) * 64 + lane_r] = oacc[mt][nt][e];
#pragma unroll
            for (int nt = 0; nt < 4; ++nt) RED[(64 + nt) * 64 + lane_r] = lsum[nt];
        }
        __syncthreads();
        if (kh == 0) {
            bf16* CAT = (bf16*)(a.ws + WS_CAT);
#pragma unroll
            for (int nt = 0; nt < 4; ++nt) { float l = lsum[nt] + RED[(64 + nt) * 64 + lane_r]; l += __shfl_xor(l, 16); l += __shfl_xor(l, 32); const float inv = 1.f / l;
                bf16* orow = CAT + (size_t)(zq_row0 + 16 * qh + 4 * nt + (n >> 2)) * DM + (4 * g + hn) * 64 + quad * 4;
#pragma unroll
                for (int mt = 0; mt < 4; ++mt) { f32x4 o = oacc[mt][nt];
#pragma unroll
                    for (int e = 0; e < 4; ++e) o[e] = (o[e] + RED[((mt * 4 + nt) * 4 + e) * 64 + lane_r]) * inv;
                    *(unsigned long long*)(orow + 16 * mt) = (unsigned long long)pk2(o.x, o.y) | ((unsigned long long)pk2(o.z, o.w) << 32); } }
        }
    }
}
__device__ __forceinline__ void gate2_item(const Args& a, int j, int item, LAS unsigned char* lds, int tid, int w, int lane) {
    int b, g, P, row0;
    if (item < 512) { b = item >> 6; const int nn = (item >> 2) & 15; g = item & 3; P = 128; row0 = b * SEQ + nn * 128; }
    else { const int s = item - 512; b = s >> 2; g = s & 3; P = ST; row0 = MP + b * ST; }
    const bf16* Z = (const bf16*)(a.ws + WS_Z);
    constexpr int VP = 136;
    LAS bf16* VB = (LAS bf16*)lds;
    __syncthreads();
    for (int e = tid; e < P * 16; e += 512) { const int q = e >> 4, c8 = (e & 15) * 8;
        *(LAS u32x4*)(VB + q * VP + c8) = *(const u32x4*)(Z + (size_t)(row0 + q) * EVEN_IN + EVB + g * 128 + c8); }
    __syncthreads();
    const int n = lane & 15, quad = lane >> 4, c0 = 16 * w;
    const int nkk = P >> 5, npt = P >> 4;
    bf16x8 av[4];
#pragma unroll
    for (int kk = 0; kk < 4; ++kk) { unsigned pk[4] = {0u, 0u, 0u, 0u};
        if (kk < nkk) {
#pragma unroll
            for (int x = 0; x < 4; ++x) { const unsigned lo = VB[(kk * 32 + quad * 8 + 2 * x) * VP + c0 + n], hi = VB[(kk * 32 + quad * 8 + 2 * x + 1) * VP + c0 + n]; pk[x] = lo | (hi << 16); } }
        av[kk] = __builtin_bit_cast(bf16x8, (u32x4){pk[0], pk[1], pk[2], pk[3]}); }
    const bf16* wsb = (const bf16*)(a.ws + WS_WSB) + (size_t)(j * 4 + g) * 128 * 128;
    bf16* CAT = (bf16*)(a.ws + WS_CAT);
    f32x4 acc8[8]; unsigned long long ur8[8]; float bias8[8];
#pragma unroll
    for (int pt = 0; pt < 8; ++pt) { acc8[pt] = (f32x4){0.f, 0.f, 0.f, 0.f}; ur8[pt] = 0ull; bias8[pt] = 0.f;
        if (pt < npt) { const int p = 16 * pt + n; const size_t row = (size_t)(row0 + p);
            ur8[pt] = *(const unsigned long long*)(Z + row * EVEN_IN + EU + g * 128 + c0 + quad * 4); bias8[pt] = a.in[15][(j * 4 + g) * 128 + p];
#pragma unroll
            for (int kk = 0; kk < 4; ++kk) if (kk < nkk) { const bf16x8 bw = *(const bf16x8*)(wsb + p * 128 + kk * 32 + quad * 8);
                acc8[pt] = __builtin_amdgcn_mfma_f32_16x16x32_bf16(av[kk], bw, acc8[pt], 0, 0, 0); } } }
#pragma unroll
    for (int pt = 0; pt < 8; ++pt) if (pt < npt) {
        const int p = 16 * pt + n; const size_t row = (size_t)(row0 + p); const unsigned long long ur = ur8[pt]; const float bias = bias8[pt]; const f32x4 acc = acc8[pt];
        const float u0 = __uint_as_float((unsigned)ur << 16), u1 = __uint_as_float((unsigned)ur & 0xffff0000u), u2 = __uint_as_float((unsigned)(ur >> 32) << 16), u3 = __uint_as_float((unsigned)(ur >> 32) & 0xffff0000u);
        *(unsigned long long*)(CAT + row * DM + 512 + g * 128 + c0 + quad * 4) = (unsigned long long)pk2(u0 * (acc[0] + bias), u1 * (acc[1] + bias)) | ((unsigned long long)pk2(u2 * (acc[2] + bias), u3 * (acc[3] + bias)) << 32);
    }
}
__device__ __forceinline__ void dsa_item(const Args& a, int j, int b, int zq_row0, int L, int P, int zk_row0, LAS unsigned char* lds, int w, int lane) {
    const bf16* Z = (const bf16*)(a.ws + WS_Z);
    constexpr int SSTR = 2048;
    LAS float* S = (LAS float*)lds;
    LAS int* IDX = (LAS int*)(lds + 65536);
    LAS float* PS = (LAS float*)(lds + 73728);
    LAS float* QS = (LAS float*)(lds + 106496);
    const int n = lane & 15, quad = lane >> 4, hn = n & 3;
    __syncthreads();
    {
        bf16x8 bq[2][2]; float wsc[2];
#pragma unroll
        for (int nt = 0; nt < 2; ++nt) { const bf16* zr = Z + (size_t)(zq_row0 + nt * 4 + (n >> 2)) * ODD_IN;
#pragma unroll
            for (int kk = 0; kk < 2; ++kk) bq[nt][kk] = *(const bf16x8*)(zr + OQI + hn * 64 + kk * 32 + quad * 8);
            wsc[nt] = bf2f(zr[OWI + hn]) * 0.0625f; }
        const int ntile = L >> 4;
        const float* cki = a.in[6] + (size_t)(j * 8 + b) * PAST * 64;
        for (int kt = w; kt < ntile; kt += 8) {
            const int p = kt * 16 + n; bf16x8 af[2];
            if (p < P) { const float* src = cki + (size_t)p * 64 + quad * 8;
#pragma unroll
                for (int kk = 0; kk < 2; ++kk) { const f32x4 x0 = *(const f32x4*)(src + kk * 32), x1 = *(const f32x4*)(src + kk * 32 + 4);
                    u32x4 pk; pk.x = pk2(x0.x, x0.y); pk.y = pk2(x0.z, x0.w); pk.z = pk2(x1.x, x1.y); pk.w = pk2(x1.z, x1.w); af[kk] = __builtin_bit_cast(bf16x8, pk); } }
            else { const bf16* src = Z + (size_t)(zk_row0 + p - P) * ODD_IN + OKI + quad * 8;
#pragma unroll
                for (int kk = 0; kk < 2; ++kk) af[kk] = *(const bf16x8*)(src + kk * 32); }
#pragma unroll
            for (int nt = 0; nt < 2; ++nt) { f32x4 acc = (f32x4){0.f, 0.f, 0.f, 0.f};
                acc = __builtin_amdgcn_mfma_f32_16x16x32_bf16(af[0], bq[nt][0], acc, 0, 0, 0);
                acc = __builtin_amdgcn_mfma_f32_16x16x32_bf16(af[1], bq[nt][1], acc, 0, 0, 0);
#pragma unroll
                for (int jj = 0; jj < 4; ++jj) { float v = fmaxf(acc[jj], 0.f) * wsc[nt]; v += __shfl_xor(v, 1); v += __shfl_xor(v, 2); acc[jj] = v; }
                if (hn == 0) *(LAS f32x4*)(S + (nt * 4 + (n >> 2)) * SSTR + kt * 16 + quad * 4) = acc; }
        }
    }
    __syncthreads();
    int nsel;
    {
        unsigned u[32];
#pragma unroll
        for (int i = 0; i < 32; ++i) { const int key = lane + 64 * i; unsigned x = 0u;
            if (key < L) { const unsigned bits = __float_as_uint(S[w * SSTR + key]); x = (bits & 0x80000000u) ? ~bits : (bits | 0x80000000u); }
            u[i] = x; }
        unsigned thr = 0u; int need = 0;
        if (L > 256) {
            for (int bit = 31; bit >= 0; --bit) { const unsigned cand = thr | (1u << bit); int c = 0;
#pragma unroll
                for (int i = 0; i < 32; ++i) c += (u[i] >= cand) ? 1 : 0;
                c = wave_sum_i(c); if (c >= 256) thr = cand; }
            int cg = 0;
#pragma unroll
            for (int i = 0; i < 32; ++i) cg += (u[i] > thr) ? 1 : 0;
            cg = wave_sum_i(cg); need = 256 - cg;
        }
        const unsigned long long lt = (1ull << lane) - 1ull;
        int base = 0, tie_seen = 0;
#pragma unroll
        for (int i = 0; i < 32; ++i) { if (64 * i < L) { const int key = lane + 64 * i;
            const bool gt = u[i] > thr, eq = (u[i] == thr) && (need > 0);
            const unsigned long long beq = __ballot(eq); const int rank = tie_seen + __popcll(beq & lt); tie_seen += __popcll(beq);
            const bool sel = gt || (eq && rank < need);
            const unsigned long long bs = __ballot(sel);
            if (sel) IDX[w * 256 + base + __popcll(bs & lt)] = key;
            base += __popcll(bs); } }
        nsel = base;
    }
    LDS_WAIT();
    const size_t qrow = (size_t)(zq_row0 + w);
    const float* cck = a.in[4] + (size_t)(j * 8 + b) * PAST * 128; const float* ccv = a.in[5] + (size_t)(j * 8 + b) * PAST * 128;
    bf16* CAT = (bf16*)(a.ws + WS_CAT);
#pragma unroll 1
    for (int g = 0; g < 2; ++g) {
#pragma unroll
        for (int hh = 0; hh < 4; ++hh) QS[(w * 4 + hh) * 64 + lane] = bf2f(Z[qrow * ODD_IN + OQ + (4 * g + hh) * 64 + lane]) * 0.125f;
        LDS_WAIT();
        const int njb = (nsel + 63) >> 6;
#pragma unroll 1
        for (int jb = 0; jb < njb; ++jb) { const int jpos = lane + 64 * jb; const bool valid = jpos < nsel;
            float kf[64];
            const int p = valid ? IDX[w * 256 + jpos] : 0;
            if (p < P) { const float* src = cck + ((size_t)p * 2 + g) * 64;
#pragma unroll
                for (int x = 0; x < 16; ++x) { const f32x4 t4 = *(const f32x4*)(src + 4 * x); kf[4 * x] = t4.x; kf[4 * x + 1] = t4.y; kf[4 * x + 2] = t4.z; kf[4 * x + 3] = t4.w; } }
            else { const bf16* src = Z + (size_t)(zk_row0 + p - P) * ODD_IN + OK + g * 64;
#pragma unroll
                for (int x = 0; x < 8; ++x) { float t8[8]; unpack8(*(const u32x4*)(src + 8 * x), t8);
#pragma unroll
                    for (int e = 0; e < 8; ++e) kf[8 * x + e] = t8[e]; } }
            float d[4] = {0.f, 0.f, 0.f, 0.f};
#pragma unroll
            for (int dq = 0; dq < 16; ++dq)
#pragma unroll
                for (int hh = 0; hh < 4; ++hh) { const f32x4 qv = *(const LAS f32x4*)(QS + (w * 4 + hh) * 64 + 4 * dq);
                    d[hh] += (qv.x * kf[4 * dq] + qv.y * kf[4 * dq + 1]) + (qv.z * kf[4 * dq + 2] + qv.w * kf[4 * dq + 3]); }
            if (valid) *(LAS f32x4*)(PS + (w * 256 + jpos) * 4) = (f32x4){d[0], d[1], d[2], d[3]};
        }
        LDS_WAIT();
        {
            f32x4 m4 = (f32x4){-1e30f, -1e30f, -1e30f, -1e30f};
#pragma unroll 1
            for (int jb = 0; jb < njb; ++jb) { const int jpos = lane + 64 * jb; if (jpos < nsel) { const f32x4 l4 = *(const LAS f32x4*)(PS + (w * 256 + jpos) * 4);
                m4.x = fmaxf(m4.x, l4.x); m4.y = fmaxf(m4.y, l4.y); m4.z = fmaxf(m4.z, l4.z); m4.w = fmaxf(m4.w, l4.w); } }
            m4.x = wave_max(m4.x); m4.y = wave_max(m4.y); m4.z = wave_max(m4.z); m4.w = wave_max(m4.w);
            f32x4 s4 = (f32x4){0.f, 0.f, 0.f, 0.f};
#pragma unroll 1
            for (int jb = 0; jb < njb; ++jb) { const int jpos = lane + 64 * jb; if (jpos < nsel) { f32x4 l4 = *(const LAS f32x4*)(PS + (w * 256 + jpos) * 4);
                l4.x = expf(l4.x - m4.x); l4.y = expf(l4.y - m4.y); l4.z = expf(l4.z - m4.z); l4.w = expf(l4.w - m4.w); s4 += l4;
                *(LAS f32x4*)(PS + (w * 256 + jpos) * 4) = l4; } }
            s4.x = 1.f / wave_sum(s4.x); s4.y = 1.f / wave_sum(s4.y); s4.z = 1.f / wave_sum(s4.z); s4.w = 1.f / wave_sum(s4.w);
#pragma unroll 1
            for (int jb = 0; jb < njb; ++jb) { const int jpos = lane + 64 * jb; if (jpos < nsel) { f32x4 l4 = *(const LAS f32x4*)(PS + (w * 256 + jpos) * 4);
                *(LAS f32x4*)(PS + (w * 256 + jpos) * 4) = l4 * s4; } }
        }
        LDS_WAIT();
        float o0 = 0.f, o1 = 0.f, o2 = 0.f, o3 = 0.f;
#pragma unroll 4
        for (int jp = 0; jp < nsel; ++jp) { const int p = IDX[w * 256 + jp];
            const float vv = (p < P) ? ccv[((size_t)p * 2 + g) * 64 + lane] : bf2f(Z[(size_t)(zk_row0 + p - P) * ODD_IN + OV + g * 64 + lane]);
            const f32x4 pw = *(const LAS f32x4*)(PS + (w * 256 + jp) * 4);
            o0 += pw.x * vv; o1 += pw.y * vv; o2 += pw.z * vv; o3 += pw.w * vv; }
        bf16* orow = CAT + qrow * DM + (4 * g) * 64 + lane;
        orow[0] = (bf16)f2bf(o0); orow[64] = (bf16)f2bf(o1); orow[128] = (bf16)f2bf(o2); orow[192] = (bf16)f2bf(o3);
        LDS_WAIT();
    }
}


#ifndef REP_SYNC
#define REP_SYNC 1
#endif
#ifndef REP_NORM
#define REP_NORM 1
#endif
#ifndef REP_G0
#define REP_G0 1
#endif
#ifndef REP_G2
#define REP_G2 1
#endif
#ifndef REP_DSA
#define REP_DSA 1
#endif
#ifndef REP_SB
#define REP_SB 1
#endif
#ifndef REP_GATE
#define REP_GATE 1
#endif
#ifndef REP_PRO
#define REP_PRO 1
#endif
template <int MODE> __device__ __forceinline__ void small_gemm_piece(const bf16* A, int lda, const bf16* Bt, int ldb, int row0, int col0, int k0, int klen, void* O, int ldo, int w, int lane) {
    const int n = lane & 15, quad = lane >> 4;
    const bf16* ap = A + (size_t)(row0 + 16 * (w & 3) + n) * lda + k0 + quad * 8;
    const bf16* bp0 = Bt + (size_t)(col0 + 32 * (w >> 2) + n) * ldb + k0 + quad * 8; const bf16* bp1 = bp0 + (size_t)16 * ldb;
    f32x4 acc0 = (f32x4){0.f, 0.f, 0.f, 0.f}, acc1 = (f32x4){0.f, 0.f, 0.f, 0.f};
#pragma unroll 1
    for (int k = 0; k < klen; k += 128) {
        bf16x8 af[4], b0[4], b1[4];
#pragma unroll
        for (int x = 0; x < 4; ++x) { af[x] = *(const bf16x8*)(ap + k + 32 * x); b0[x] = *(const bf16x8*)(bp0 + k + 32 * x); b1[x] = *(const bf16x8*)(bp1 + k + 32 * x); }
#pragma unroll
        for (int x = 0; x < 4; ++x) { acc0 = __builtin_amdgcn_mfma_f32_16x16x32_bf16(af[x], b0[x], acc0, 0, 0, 0); acc1 = __builtin_amdgcn_mfma_f32_16x16x32_bf16(af[x], b1[x], acc1, 0, 0, 0); }
    }
    const int r = row0 + 16 * (w & 3) + quad * 4, c = col0 + 32 * (w >> 2) + n;
#pragma unroll
    for (int jj = 0; jj < 4; ++jj) {
        if (MODE == 0) { const float x0 = fmaxf(acc0[jj], 0.f), x1 = fmaxf(acc1[jj], 0.f); bf16* o = (bf16*)O + (size_t)(r + jj) * ldo + c; o[0] = (bf16)f2bf(x0 * x0); o[16] = (bf16)f2bf(x1 * x1); }
        else { float* o = (float*)O + (size_t)(r + jj) * ldo + c; atomicAdd(o, acc0[jj]); atomicAdd(o + 16, acc1[jj]); }
    }
}
template <int W> __device__ __forceinline__ void vt_tile_store(const LAS bf16* vt, bf16* dst, int pitch, int tid) {
    if (tid < W) {
        bf16* o = dst + (size_t)tid * pitch;
#pragma unroll
        for (int c8 = 0; c8 < 8; ++c8) { unsigned pk[4];
#pragma unroll
            for (int x = 0; x < 4; ++x) { const unsigned lo = vt[(c8 * 8 + 2 * x) * W + tid], hi = vt[(c8 * 8 + 2 * x + 1) * W + tid]; pk[x] = lo | (hi << 16); }
            *(u32x4*)(o + c8 * 8) = (u32x4){pk[0], pk[1], pk[2], pk[3]}; }
    }
}
#define XB_TMO      128
#define XB_XCNT(j)  (256  + 64 * (j))
#define XB_XSUB(j)  (1280 + 64 * (j))
#define XB_XGEN(j)  (2304 + 64 * (j))
#define XB_TOP      3328
#define XB_TOPGEN   3392
#define XCD_BAR_WORDS 3456
#define XB_SPIN_CAP (1u << 18)

__device__ __forceinline__ unsigned xb_ld(unsigned* p)              { return __hip_atomic_load(p, __ATOMIC_RELAXED, __HIP_MEMORY_SCOPE_AGENT); }
__device__ __forceinline__ unsigned xb_add(unsigned* p, unsigned v) { return __hip_atomic_fetch_add(p, v, __ATOMIC_RELAXED, __HIP_MEMORY_SCOPE_AGENT); }
__device__ __forceinline__ unsigned xb_xcc_id() { return (unsigned)__builtin_amdgcn_s_getreg((3 << 11) | 20) & 0xFu; }
#define XB_SPIN(cond, bar) do { unsigned _sp = 0; while (cond) { __builtin_amdgcn_s_sleep(1); \
    if ((++_sp & 255u) == 0u) { if (xb_ld(&(bar)[XB_TMO])) break; if (_sp > XB_SPIN_CAP) { atomicAdd(&(bar)[XB_TMO], 1u); break; } } } } while (0)

struct XcdBarrier {
    unsigned* bar; unsigned x;
    volatile LAS unsigned* st;
};

__device__ __forceinline__ XcdBarrier xcd_barrier_post(unsigned* bar, volatile LAS unsigned* st) {
    XcdBarrier b; b.bar = bar; b.x = xb_xcc_id(); b.st = st;
    if (threadIdx.x == 0) (void)xb_add(&bar[XB_XCNT(b.x)], 1u);
    return b;
}
__device__ __forceinline__ void xcd_barrier_complete(unsigned* bar, unsigned x, unsigned& nloc, unsigned& nx) {
    const unsigned G = gridDim.x * gridDim.y * gridDim.z;
    unsigned sum, cnt, mine, sp = 0u;
    for (;;) {
        sum = 0u; cnt = 0u; mine = 0u;
#pragma unroll
        for (unsigned j = 0; j < 16; ++j) { const unsigned c = xb_ld(&bar[XB_XCNT(j)]); sum += c; cnt += (c > 0u) ? 1u : 0u; mine = (j == x) ? c : mine; }
        if (sum == G) break;
        __builtin_amdgcn_s_sleep(1);
        if ((++sp & 255u) == 0u) { if (xb_ld(&bar[XB_TMO])) break; if (sp > XB_SPIN_CAP) { atomicAdd(&bar[XB_TMO], 1u); break; } }
    }
    nloc = mine > 0u ? mine : 1u; nx = cnt > 0u ? cnt : 1u;
}

__device__ __forceinline__ void xcd_barrier(const XcdBarrier& b) {
    asm volatile("s_waitcnt vmcnt(0)" ::: "memory");
    __syncthreads();
    if (threadIdx.x == 0) {
        unsigned* bar = b.bar;
        __builtin_amdgcn_s_waitcnt(0);
        unsigned nloc = b.st[0], nx = b.st[1];
        if (nloc == 0u) { xcd_barrier_complete(bar, b.x, nloc, nx); b.st[0] = nloc; b.st[1] = nx; }
        const unsigned old = xb_add(&bar[XB_XSUB(b.x)], 1u);
        const unsigned gen = old / nloc;
        if (old + 1u == (gen + 1u) * nloc) {
            __builtin_amdgcn_fence(__ATOMIC_RELEASE, "agent");
            asm volatile("s_waitcnt vmcnt(0)" ::: "memory");
            const unsigned og = xb_add(&bar[XB_TOP], 1u);
            const unsigned tg = og / nx;
            if (og + 1u == (tg + 1u) * nx) xb_add(&bar[XB_TOPGEN], 1u);
            else XB_SPIN(xb_ld(&bar[XB_TOPGEN]) == tg, bar);
            __builtin_amdgcn_fence(__ATOMIC_ACQUIRE, "agent");
            xb_add(&bar[XB_XGEN(b.x)], 1u);
            asm volatile("s_waitcnt vmcnt(0)" ::: "memory");
        } else {
            XB_SPIN(xb_ld(&bar[XB_XGEN(b.x)]) == gen, bar);
            __builtin_amdgcn_fence(__ATOMIC_ACQUIRE, "agent");
            asm volatile("s_waitcnt vmcnt(0)" ::: "memory");
        }
    }
    __syncthreads();
}

#ifndef PROBE_DUP_SUB
#define PROBE_DUP_SUB -1
#endif
constexpr int N_PHASES = 1 + 4 * (PROBE_DUP_SUB >= 0 ? 9 : 8);
__global__ void __launch_bounds__(512, 2) mega_fwd(Args a) {
    extern __shared__ __attribute__((aligned(16))) unsigned char lds_raw[];
    LAS unsigned char* lds = (LAS unsigned char*)lds_raw;
    cg::grid_group grid = cg::this_grid();
    const int G = gridDim.x;
    typedef const __attribute__((address_space(4))) unsigned char* kptr_t; typedef const float* cfp_t; typedef float* fp_t; typedef unsigned char* ucp_t;
    const kptr_t kp0 = (kptr_t)__builtin_amdgcn_kernarg_segment_ptr();
    unsigned char* ws0 = a.ws;
    if (threadIdx.x < 4) ((LAS unsigned*)(lds + LDS_BARST))[threadIdx.x] = 0u;
    __syncthreads();
    (void)xcd_barrier_post((unsigned*)(ws0 + WS_CTL), (volatile LAS unsigned*)(lds + LDS_BARST));
#pragma unroll 1
    for (int pi = a.ph_lo; pi < a.ph_hi; ++pi) {
#if PROBE_DUP_SUB >= 0
        int ph = pi; if (pi > 0) { const int l9 = (pi - 1) / 9, s9 = (pi - 1) % 9; ph = 1 + l9 * 8 + (s9 <= PROBE_DUP_SUB ? s9 : s9 - 1); }
#else
        const int ph = pi;
#endif
        kptr_t kp = kp0; asm volatile("" : "+s"(kp));
        Args al;
#pragma unroll
        for (int i = 0; i < 24; ++i) al.in[i] = *(const cfp_t __attribute__((address_space(4)))*)(kp + 8 * i);
        al.out = *(const fp_t __attribute__((address_space(4)))*)(kp + 192); al.ws = *(const ucp_t __attribute__((address_space(4)))*)(kp + 200);
        al.ph_lo = a.ph_lo; al.ph_hi = a.ph_hi;
        unsigned char* ws = al.ws;
        bf16* H = (bf16*)(ws + WS_H); bf16* Zb = (bf16*)(ws + WS_Z); bf16* CAT = (bf16*)(ws + WS_CAT); bf16* ACT = (bf16*)(ws + WS_ACT);
        int tid_l = threadIdx.x; asm volatile("" : "+v"(tid_l));
        const int tid = tid_l, lane = tid & 63, w = __builtin_amdgcn_readfirstlane(tid >> 6);
        const int gw = blockIdx.x * 8 + w, NGW = G * 8;
        if (ph == 0) { for (int rep_ = 0; rep_ < REP_PRO; ++rep_) { p_prologue(al, lds, gw, NGW, w, lane); } }
        else {
            const int li = (ph - 1) >> 3, sub = (ph - 1) & 7, j = li >> 1; const bool odd = li & 1;
            if (sub == 0) { for (int rep_ = 0; rep_ < REP_NORM; ++rep_) { if (li > 0) p_norm(al, al.in[8] + li * DM, gw, NGW, lane); } }
            else if (sub == 1) {
                const int N = odd ? ODD_IN : EVEN_IN;
                const bf16* Wt = odd ? (const bf16*)(ws + WS_WINO) + (size_t)j * ODD_IN * DM : (const bf16*)(ws + WS_WINE) + (size_t)j * EVEN_IN * DM;
                pg8::Gemm g{H, Wt, MT, N, DM}; pg8::StaticOrder S; S.init(MT, N, G, (int)blockIdx.x);
                pg8::EpiBf16<0> E{Zb, N};
                for (int rep_ = 0; rep_ < REP_G0; ++rep_) { pg8::gemm_phase<pg8::EpiBf16<0>, pg8::StaticOrder, true, true>(lds, g, S, E, w); }
                {
                    const int nwg = (MT / 256) * (N / 256), nfull = nwg / G, first_idle = nwg - nfull * G;
                    const int nidle = G - first_idle; LAS bf16* vts = (LAS bf16*)lds;
                    if ((int)blockIdx.x >= first_idle && nidle > 0) {
                        for (int tile = (int)blockIdx.x - first_idle; tile < 128; tile += nidle) { __syncthreads();
                            int lane_c = lane; asm volatile("" : "+v"(lane_c));
                            if (odd) {
#pragma unroll 1
                                for (int i = 0; i < 8; ++i) cache_c_row(al, j, tile * 64 + w * 8 + i, lane_c, vts + (w * 8 + i) * 128);
                                __syncthreads();
                                vt_tile_store<128>(vts, (bf16*)(ws + WS_VTS) + (size_t)(tile >> 4) * 2 * 64 * SKL + (tile & 15) * 64, SKL, tid);
                            } else {
#pragma unroll 1
                                for (int i = 0; i < 8; ++i) cache_a_row(al, j, tile * 64 + w * 8 + i, lane_c, vts + (w * 8 + i) * 512);
                                __syncthreads();
                                vt_tile_store<512>(vts, (bf16*)(ws + WS_VTSA) + (size_t)(tile >> 4) * 8 * 64 * SKL + (tile & 15) * 64, SKL, tid);
                            } }
                    }
                }
            }
            else if (sub == 2) {
                LAS bf16* vts = (LAS bf16*)lds;
                if (odd) {
                    int lane_o = lane; asm volatile("" : "+v"(lane_o));
                    for (int tile = blockIdx.x; tile < 256; tile += G) { __syncthreads();
                        OdRaw cur; odd_load(al, j, tile * 64 + w * 8, lane_o, cur);
#pragma unroll 1
                        for (int i = 0; i < 8; ++i) { OdRaw nx; odd_load(al, j, tile * 64 + w * 8 + (i < 7 ? i + 1 : i), lane_o, nx);
                            odd_post_row(al, j, tile * 64 + w * 8 + i, lane_o, vts + (w * 8 + i) * 128, true, cur); cur = nx; }
                        __syncthreads();
                        vt_tile_store<128>(vts, (bf16*)(ws + WS_VTP) + (size_t)(tile >> 5) * 2 * 64 * VTL + (tile & 31) * 64, VTL, tid); }
                    for (int r = MP + gw; r < MT; r += NGW) { OdRaw one; odd_load(al, j, r, lane_o, one); odd_post_row(al, j, r, lane_o, vts, false, one); }
                } else {
                    int lane_e = lane; asm volatile("" : "+v"(lane_e));
                    for (int tile = blockIdx.x; tile < 256; tile += G) { __syncthreads();
                        EvRaw cur = even_load(Zb + (size_t)(tile * 64 + w * 8) * EVEN_IN, lane_e);
#pragma unroll 1
                        for (int i = 0; i < 8; ++i) { const EvRaw nx = even_load(Zb + (size_t)(tile * 64 + w * 8 + (i < 7 ? i + 1 : i)) * EVEN_IN, lane_e);
                            even_post_row(al, j, tile * 64 + w * 8 + i, lane_e, vts + (w * 8 + i) * 512, true, cur); cur = nx; }
                        __syncthreads();
                        vt_tile_store<512>(vts, (bf16*)(ws + WS_VTA) + (size_t)(tile >> 5) * 8 * 64 * VTL + (tile & 31) * 64, VTL, tid); }
                    for (int r = MP + gw; r < MT; r += NGW) { const EvRaw one = even_load(Zb + (size_t)r * EVEN_IN, lane_e); even_post_row(al, j, r, lane_e, vts, false, one); }
                }
            }
            else if (sub == 3) {
                if (odd) {
                  for (int rep_ = 0; rep_ < REP_DSA; ++rep_) {
                    unsigned* ticket = (unsigned*)(ws + WS_CTL) + 3584 + 64 * (j + 2 * rep_);
                    volatile LAS int* nxt = (volatile LAS int*)(lds + LDS_BARST + 8);
                    for (;;) {
                        __syncthreads();
                        if (tid == 0) *nxt = (int)__hip_atomic_fetch_add(ticket, 1u, __ATOMIC_RELAXED, __HIP_MEMORY_SCOPE_AGENT);
                        __syncthreads();
                        const int t = *nxt;
                        if (t >= 520) break;
                        if (t >= 256 && t < 264) { const int b = t - 256;
                            DsaSrc src{(const bf16*)(ws + WS_KS) + (size_t)b * SKL * 128, 128, (const bf16*)(ws + WS_KIS) + (size_t)b * SKL * 64, 64, (const bf16*)(ws + WS_VTS) + (size_t)b * 2 * 64 * SKL, SKL};
                            dsa2_item(al, src, MP + b * ST, PAST + ST, lds, w, lane); }
                        else { const int kk = t < 256 ? t : t - 8; const int c = 31 - (kk >> 4), rem = kk & 15, b = rem >> 1, hf = rem & 1;
                            const bf16* zb = Zb + (size_t)b * SEQ * ODD_IN;
                            DsaSrc src{zb + OK, ODD_IN, zb + OKI, ODD_IN, (const bf16*)(ws + WS_VTP) + (size_t)b * 2 * 64 * VTL, VTL};
                            dsa2_item(al, src, b * SEQ + c * 64 + hf * 32, 64 * (c + 1), lds, w, lane); }
                    }
                  }
                } else {
                    for (int rep_ = 0; rep_ < REP_SB; ++rep_) {
                        unsigned* ticket = (unsigned*)(ws + WS_CTL) + 3840 + 64 * (j + 2 * rep_);
                        volatile LAS int* nxt = (volatile LAS int*)(lds + LDS_BARST + 8);
                        for (;;) {
                            __syncthreads();
                            if (tid == 0) *nxt = (int)__hip_atomic_fetch_add(ticket, 1u, __ATOMIC_RELAXED, __HIP_MEMORY_SCOPE_AGENT);
                            __syncthreads();
                            const int t = *nxt;
                            if (t >= 1040) break;
                            if (t < 16) { const int s = t * 8 + w, bh = s >> 1, hf = s & 1, b = bh >> 3, h = bh & 7;
                                SbSrc src{(const bf16*)(ws + WS_KSA) + (size_t)b * SKL * 512 + h * 64, 512, (const bf16*)(ws + WS_VTSA) + (size_t)bh * 64 * SKL, SKL};
                                sb2_wave_item(al, src, MP + b * ST + hf * 16, h * 64, PAST + hf * 16, lane); }
                            else { const int id = (t - 16) * 8 + w, bh = id >> 7, qt = 127 - (id & 127), b = bh >> 3, h = bh & 7;
                                SbSrc src{Zb + (size_t)b * SEQ * EVEN_IN + EK + h * 64, EVEN_IN, (const bf16*)(ws + WS_VTA) + (size_t)bh * 64 * VTL, VTL};
                                sb2_wave_item(al, src, b * SEQ + qt * 16, h * 64, qt * 16, lane); }
                        }
                    }
                    for (int rep_ = 0; rep_ < REP_GATE; ++rep_) { for (int it = blockIdx.x; it < 512 + 32; it += G) gate2_item(al, j, it, lds, tid, w, lane); }
                }
            }
            else if (sub == 4) {
                const bf16* Wo = (const bf16*)(ws + WS_WOUT) + (size_t)li * DM * DM;
                pg8::Gemm g{CAT, Wo, MP, DM, DM}; pg8::StaticOrder S; S.init(MP, DM, G, (int)blockIdx.x);
                pg8::EpiRes E{al.out, DM};
                pg8::gemm_phase<pg8::EpiRes, pg8::StaticOrder, true, true>(lds, g, S, E, w);
                for (int pc = blockIdx.x; pc < 256; pc += G) { const int st = pc >> 2, ks = pc & 3;
                    small_gemm_piece<1>(CAT, DM, Wo, DM, MP + (st >> 4) * 64, (st & 15) * 64, ks * 256, 256, al.out, DM, w, lane); }
            }
            else if (sub == 5) { for (int rep_ = 0; rep_ < REP_NORM; ++rep_) { p_norm(al, al.in[9] + li * DM, gw, NGW, lane); } }
            else if (sub == 6) {
                const bf16* W1 = (const bf16*)(ws + WS_W1) + (size_t)li * FF * DM;
                pg8::Gemm g{H, W1, MP, FF, DM}; pg8::StaticOrder S; S.init(MP, FF, G, (int)blockIdx.x);
                pg8::EpiBf16<2> E{ACT, FF};
                for (int rep_ = 0; rep_ < REP_G2; ++rep_) { pg8::gemm_phase<pg8::EpiBf16<2>, pg8::StaticOrder, true, true>(lds, g, S, E, w); }
                for (int pc = blockIdx.x; pc < 256; pc += G) small_gemm_piece<0>(H, DM, W1, DM, MP + (pc >> 6) * 64, (pc & 63) * 64, 0, DM, ACT, FF, w, lane);
            }
            else {
                const bf16* W2 = (const bf16*)(ws + WS_W2) + (size_t)li * DM * FF;
                pg8::Gemm g{ACT, W2, MP, DM, FF}; pg8::StaticOrder S; S.init(MP, DM, G, (int)blockIdx.x);
                pg8::EpiRes E{al.out, DM};
                pg8::gemm_phase<pg8::EpiRes, pg8::StaticOrder, true, true>(lds, g, S, E, w);
                for (int pc = blockIdx.x; pc < 256; pc += G) { const int st = pc >> 2, ks = pc & 3;
                    small_gemm_piece<1>(ACT, FF, W2, FF, MP + (st >> 4) * 64, (st & 15) * 64, ks * 1024, 1024, al.out, DM, w, lane); }
            }
        }
        if (pi + 1 < al.ph_hi) { for (int rep_ = 0; rep_ < REP_SYNC; ++rep_) { if (al.ph_lo < 0) grid.sync();   { XcdBarrier xb; xb.bar = (unsigned*)(ws + WS_CTL); xb.x = xb_xcc_id(); xb.st = (volatile LAS unsigned*)(lds + LDS_BARST); xcd_barrier(xb); } } }
    }
}

#ifndef MK_MULTI
#define MK_MULTI 0
#endif
extern "C" void kernel_launch(void* const* d_in, const int* in_sizes, int n_in, void* d_out, int out_size, void* d_ws, size_t ws_size, hipStream_t stream) {
    static int grid = 0;
    if (grid == 0) {
        int dev = 0, cus = 0, per_cu = 0;
        hipGetDevice(&dev); hipDeviceGetAttribute(&cus, hipDeviceAttributeMultiprocessorCount, dev);
        if (hipFuncSetAttribute((const void*)mega_fwd, hipFuncAttributeMaxDynamicSharedMemorySize, LDS_BYTES) != hipSuccess) fprintf(stderr, "kernel_launch: hipFuncSetAttribute failed\n");
        if (hipOccupancyMaxActiveBlocksPerMultiprocessor(&per_cu, (const void*)mega_fwd, 512, LDS_BYTES) != hipSuccess || per_cu < 1) { fprintf(stderr, "kernel_launch: occupancy query says %d\n", per_cu); per_cu = 1; }
        (void)hipGetLastError();
        if (cus <= 0) cus = 256;
        grid = cus;
        if (n_in != 24 || (size_t)out_size != OUT_TOTAL || ws_size < WS_END2) fprintf(stderr, "kernel_launch: unexpected sizes n_in %d out %d ws %zu\n", n_in, out_size, ws_size);
    }
    Args a{};
    for (int i = 0; i < 24; ++i) a.in[i] = (const float*)d_in[i];
    a.out = (float*)d_out; a.ws = (unsigned char*)d_ws;
#if MK_MULTI
    for (int ph = 0; ph < N_PHASES; ++ph) { if (ph == 1) continue; a.ph_lo = ph; a.ph_hi = ph + 1; hipLaunchKernelGGL(mega_fwd, dim3(grid), dim3(512), LDS_BYTES, stream, a); }
#else
    if (hipMemsetAsync((unsigned char*)d_ws + WS_CTL, 0, CTL_BYTES, stream) != hipSuccess) fprintf(stderr, "kernel_launch: memset failed\n");
    a.ph_lo = 0; a.ph_hi = N_PHASES;
    void* args[] = {&a};
    hipError_t e = hipLaunchCooperativeKernel((const void*)mega_fwd, dim3(grid), dim3(512), args, LDS_BYTES, stream);
    if (e != hipSuccess) fprintf(stderr, "kernel_launch: cooperative launch failed: %s (grid %d)\n", hipGetErrorString(e), grid);
#endif
}
```

```cpp
#include <hip/hip_runtime.h>
#include <hip/hip_cooperative_groups.h>
#include <cstdio>
#include <cstdint>
#include <cstddef>
namespace cg = cooperative_groups;
namespace pg8 {
#define PG8_LAS __attribute__((address_space(3)))
typedef unsigned short bf16_t;
typedef short bf16x8 __attribute__((ext_vector_type(8)));
typedef float f32x4 __attribute__((ext_vector_type(4)));
typedef unsigned u32x4 __attribute__((ext_vector_type(4)));
constexpr int BM = 256, BK = 64, HALF = 128, HTB = HALF * BK * 2  , STAGE_BYTES = 8 * HTB, NXCD = 8, WGM = 8;

__host__ __device__ __forceinline__ int lds_byte(int r, int c) { const int st = (r >> 4) * 2 + (c >> 5), rr = r & 15, cc = c & 31, ob = rr * 64 + cc * 2; return st * 1024 + (ob ^ (((ob >> 9) & 1) << 5)); }
__host__ __device__ __forceinline__ void stage_rc(int b, int& R, int& C) { const int st = b / 1024, sb = b % 1024, swz = sb ^ (((sb >> 9) & 1) << 5); R = (st >> 1) * 16 + swz / 64; C = (st & 1) * 32 + (swz % 64) / 2; }
__host__ __device__ __forceinline__ int perm32(int rho) { const int n = rho >> 4, i = rho & 15; return 8 * (i >> 2) + 4 * n + (i & 3); }

struct Unit { int pm, pn; };
struct Gemm { const bf16_t* A; const bf16_t* Bt; int M, N, K; };

struct StaticOrder {
    int nM, nN, nwg, G, c;
    __host__ __device__ void init(int M, int N, int G_, int c_) { nM = M / BM; nN = N / BM; nwg = nM * nN; G = G_; c = c_; }
    __host__ __device__ bool next(int i, Unit& u) const {
        const long L = (long)i * G + c; if (L >= nwg) return false;
        int wgid = (int)L; { const int q = nwg / NXCD, r = nwg % NXCD, xcd = wgid % NXCD, off = wgid / NXCD; wgid = (xcd < r ? xcd * (q + 1) : r * (q + 1) + (xcd - r) * q) + off; }
        const int nig = WGM * nN, gid = wgid / nig, fm = gid * WGM, gsz = (nM - fm) < WGM ? (nM - fm) : WGM;
        u.pm = fm + ((wgid % nig) % gsz); u.pn = (wgid % nig) / gsz; return true;
    }
    __device__ __forceinline__ void a_ready(const Unit&) const {}
    __device__ __forceinline__ void done(const Unit&) const {}
};

__device__ __forceinline__ unsigned cvt_pk_bf16(float lo, float hi) { unsigned r; asm volatile("v_cvt_pk_bf16_f32 %0, %1, %2" : "=v"(r) : "v"(lo), "v"(hi)); return r; }
template <int ACT  > struct EpiBf16 {
    static constexpr bool PERM = true, AFTER_DRAIN = false;
    bf16_t* O; int ldc;
    __device__ __forceinline__ void operator()(const f32x4 (&acc)[2][2][4][2], const Unit& u, int wr, int wc, int fr, int fq) const {
        const int row0 = u.pm * BM + wr * 64 + fr, col0 = u.pn * BM + wc * 32 + 8 * fq;
#pragma unroll
        for (int ai = 0; ai < 2; ++ai)
#pragma unroll
            for (int m = 0; m < 4; ++m) { bf16_t* rowp = O + (size_t)(row0 + ai * HALF + m * 16) * ldc + col0;
#pragma unroll
                for (int bj = 0; bj < 2; ++bj) { f32x4 v0 = acc[ai][bj][m][0], v1 = acc[ai][bj][m][1];
                    if (ACT == 2) {
#pragma unroll
                        for (int e = 0; e < 4; ++e) { const float a0 = fmaxf(v0[e], 0.f), a1 = fmaxf(v1[e], 0.f); v0[e] = a0 * a0; v1[e] = a1 * a1; } }
                    u32x4 w; w.x = cvt_pk_bf16(v0[0], v0[1]); w.y = cvt_pk_bf16(v0[2], v0[3]); w.z = cvt_pk_bf16(v1[0], v1[1]); w.w = cvt_pk_bf16(v1[2], v1[3]);
                    *(u32x4*)(rowp + bj * HALF) = w; } }
    }
};
struct EpiRes {
    static constexpr bool PERM = false, AFTER_DRAIN = false;
    float* X; int ldc;
    __device__ __forceinline__ void operator()(const f32x4 (&acc)[2][2][4][2], const Unit& u, int wr, int wc, int fr, int fq) const {
        const int row0 = u.pm * BM + wr * 64 + fr, col0 = u.pn * BM + wc * 32 + 4 * fq;
        f32x4 cur[4], nxt[4];
        { const float* rowp = X + (size_t)row0 * ldc + col0;
#pragma unroll
          for (int q = 0; q < 4; ++q) cur[q] = *(const f32x4*)(rowp + (q >> 1) * HALF + (q & 1) * 16); }
#pragma unroll
        for (int gidx = 0; gidx < 8; ++gidx) { const int ai = gidx >> 2, m = gidx & 3;
            float* rowp = X + (size_t)(row0 + ai * HALF + m * 16) * ldc + col0;
            if (gidx < 7) { const int ai2 = (gidx + 1) >> 2, m2 = (gidx + 1) & 3; const float* rp2 = X + (size_t)(row0 + ai2 * HALF + m2 * 16) * ldc + col0;
#pragma unroll
                for (int q = 0; q < 4; ++q) nxt[q] = *(const f32x4*)(rp2 + (q >> 1) * HALF + (q & 1) * 16); }
#pragma unroll
            for (int q = 0; q < 4; ++q) *(f32x4*)(rowp + (q >> 1) * HALF + (q & 1) * 16) = cur[q] + acc[ai][q >> 1][m][q & 1];
            asm volatile("" ::: "memory");
#pragma unroll
            for (int q = 0; q < 4; ++q) cur[q] = nxt[q]; }
    }
};
template <class Epi, class Sched, bool ALIGN_EPI = false, bool SP2 = false>
__device__ __forceinline__ void gemm_phase(PG8_LAS unsigned char* lds, const Gemm g, const Sched& S, const Epi& E, int wid_in) {
    int tid_l = threadIdx.x; asm volatile("" : "+v"(tid_l));
    const int tid = tid_l, wid = __builtin_amdgcn_readfirstlane(tid >> 6), lane = tid & 63, wr = wid >> 2, wc = wid & 3, fr = lane & 15, fq = lane >> 4;
    const int K = g.K, nt = K / BK;
    unsigned voffA[2], voffB[2];
#pragma unroll
    for (int i = 0; i < 2; ++i) { int R, C; stage_rc(tid * 16 + i * 8192, R, C); const int Rb = Epi::PERM ? ((R & ~31) + perm32(R & 31)) : R;
        voffA[i] = (unsigned)(R * K + C) * 2u; voffB[i] = (unsigned)(Rb * K + C) * 2u; }
    const size_t kstep = (size_t)(BK * 2);
    const size_t hstep = (size_t)HALF * K * 2;
    const size_t tstep = 2 * hstep;
    const unsigned ldsw = (unsigned)wid * 1024u;
    const int aoff = lds_byte(wr * 64 + fr, fq * 8), boff = lds_byte(wc * 32 + fr, fq * 8);
#define PG8_SA(b, h) (((b) * 2 + (h)) * HTB)
#define PG8_SB(b, h) ((4 + (b) * 2 + (h)) * HTB)
#define PG8_STAGE(bufoff, gbase, voff) do { _Pragma("unroll") for (int _i = 0; _i < 2; ++_i) \
        __builtin_amdgcn_global_load_lds((const unsigned*)((const char*)(gbase) + (voff)[_i]), (PG8_LAS unsigned*)(lds + (bufoff) + ldsw + _i * 8192), 16, 0, 0); } while (0)
#define PG8_LDA(dst, b, h) do { _Pragma("unroll") for (int m = 0; m < 4; ++m) _Pragma("unroll") for (int k = 0; k < 2; ++k) dst[m][k] = *(const PG8_LAS bf16x8*)(lds + PG8_SA(b, h) + aoff + m * 2048 + k * 1024); } while (0)
#define PG8_LDB(dst, b, h) do { _Pragma("unroll") for (int n = 0; n < 2; ++n) _Pragma("unroll") for (int k = 0; k < 2; ++k) dst[n][k] = *(const PG8_LAS bf16x8*)(lds + PG8_SB(b, h) + boff + n * 2048 + k * 1024); } while (0)
#define PG8_MMA(ai, bj, At, Bt) do { __builtin_amdgcn_s_setprio(1); _Pragma("unroll") for (int m = 0; m < 4; ++m) _Pragma("unroll") for (int n = 0; n < 2; ++n) _Pragma("unroll") for (int k = 0; k < 2; ++k) \
        acc[ai][bj][m][n] = __builtin_amdgcn_mfma_f32_16x16x32_bf16(Bt[n][k], At[m][k], acc[ai][bj][m][n], 0, 0, 0); __builtin_amdgcn_s_setprio(0); } while (0)
#define PG8_WAIT_V(n) asm volatile("s_waitcnt vmcnt(" #n ")" ::: "memory")
#define PG8_WAIT_L(n) asm volatile("s_waitcnt lgkmcnt(" #n ")" ::: "memory")
#define PG8_BAR __builtin_amdgcn_s_barrier()
#define PG8_SCHED __builtin_amdgcn_sched_barrier(0)
    Unit cur, nxt; int ui = 0;
    if (!S.next(0, cur)) return;
    f32x4 acc[2][2][4][2];
#pragma unroll
    for (int a = 0; a < 2; ++a)
#pragma unroll
        for (int b = 0; b < 2; ++b)
#pragma unroll
            for (int m = 0; m < 4; ++m)
#pragma unroll
                for (int n = 0; n < 2; ++n) acc[a][b][m][n] = (f32x4){0.f, 0.f, 0.f, 0.f};
    bf16x8 At[4][2], B0[2][2], B1[2][2];
    const char* cA = (const char*)g.A + (size_t)cur.pm * tstep; const char* cB = (const char*)g.Bt + (size_t)cur.pn * tstep;
    S.a_ready(cur);
    if constexpr (SP2) {
        PG8_STAGE(PG8_SB(0, 0), cB, voffB); PG8_STAGE(PG8_SB(0, 1), cB + hstep, voffB); PG8_STAGE(PG8_SA(0, 0), cA, voffA); PG8_STAGE(PG8_SA(0, 1), cA + hstep, voffA);
        if (wr == 1) PG8_BAR;
        PG8_WAIT_V(2); PG8_BAR;
        PG8_STAGE(PG8_SB(1, 0), cB + kstep, voffB); PG8_STAGE(PG8_SA(1, 0), cA + kstep, voffA); PG8_STAGE(PG8_SB(1, 1), cB + hstep + kstep, voffB);
        PG8_WAIT_V(6); PG8_BAR;
    } else {
        PG8_STAGE(PG8_SB(0, 0), cB, voffB); PG8_STAGE(PG8_SA(0, 0), cA, voffA); PG8_STAGE(PG8_SB(0, 1), cB + hstep, voffB); PG8_STAGE(PG8_SA(0, 1), cA + hstep, voffA);
        if (wr == 1) PG8_BAR;
        PG8_WAIT_V(4); PG8_BAR;
        PG8_STAGE(PG8_SB(1, 0), cB + kstep, voffB); PG8_STAGE(PG8_SA(1, 0), cA + kstep, voffA); PG8_STAGE(PG8_SB(1, 1), cB + hstep + kstep, voffB);
        PG8_WAIT_V(6); PG8_BAR;
    }
    for (;;) {
        const bool has_next = S.next(ui + 1, nxt);
        const char* nA = has_next ? (const char*)g.A + (size_t)nxt.pm * tstep : cA; const char* nB = has_next ? (const char*)g.Bt + (size_t)nxt.pn * tstep : cB;
        for (int t = 0; t < nt; t += 2) {
            const bool last = (t == nt - 2);
            const char* a1 = cA + (size_t)(t + 1) * kstep;
            const char* a2 = last ? nA : cA + (size_t)(t + 2) * kstep; const char* b2 = last ? nB : cB + (size_t)(t + 2) * kstep;
            const char* a3 = a2 + kstep; const char* b3 = b2 + kstep;
            if (last && has_next) S.a_ready(nxt);
            if constexpr (SP2) {
            PG8_LDB(B0, 0, 0); PG8_LDB(B1, 0, 1); PG8_SCHED; PG8_LDA(At, 0, 0); PG8_STAGE(PG8_SA(1, 1), a1 + hstep, voffA);
            PG8_WAIT_V(8); PG8_WAIT_L(0); PG8_BAR; PG8_MMA(0, 0, At, B0); PG8_MMA(0, 1, At, B1); PG8_BAR; PG8_SCHED;
            PG8_LDA(At, 0, 1); PG8_STAGE(PG8_SB(0, 0), b2, voffB); PG8_STAGE(PG8_SB(0, 1), b2 + hstep, voffB); PG8_STAGE(PG8_SA(0, 0), a2, voffA);
            PG8_WAIT_V(8); PG8_WAIT_L(0); PG8_BAR; PG8_MMA(1, 0, At, B0); PG8_MMA(1, 1, At, B1); PG8_BAR; PG8_SCHED;
            PG8_LDB(B0, 1, 0); PG8_LDB(B1, 1, 1); PG8_SCHED; PG8_LDA(At, 1, 0); PG8_STAGE(PG8_SA(0, 1), a2 + hstep, voffA);
            PG8_WAIT_V(8); PG8_WAIT_L(0); PG8_BAR; PG8_MMA(0, 0, At, B0); PG8_MMA(0, 1, At, B1); PG8_BAR; PG8_SCHED;
            PG8_LDA(At, 1, 1); PG8_STAGE(PG8_SB(1, 0), b3, voffB); PG8_STAGE(PG8_SB(1, 1), b3 + hstep, voffB); PG8_STAGE(PG8_SA(1, 0), a3, voffA);
            PG8_WAIT_V(8); PG8_WAIT_L(0); PG8_BAR; PG8_MMA(1, 0, At, B0); PG8_MMA(1, 1, At, B1); PG8_BAR; PG8_SCHED;
            } else {
            PG8_LDB(B0, 0, 0); PG8_SCHED; PG8_LDA(At, 0, 0); PG8_STAGE(PG8_SA(1, 1), a1 + hstep, voffA);
            PG8_WAIT_L(8); PG8_BAR; PG8_WAIT_L(0); PG8_MMA(0, 0, At, B0); PG8_BAR; PG8_SCHED;
            PG8_LDB(B1, 0, 1); PG8_STAGE(PG8_SB(0, 0), b2, voffB);
            PG8_BAR; PG8_WAIT_L(0); PG8_MMA(0, 1, At, B1); PG8_BAR;
            PG8_LDA(At, 0, 1); PG8_STAGE(PG8_SA(0, 0), a2, voffA);
            PG8_BAR; PG8_WAIT_L(0); PG8_MMA(1, 0, At, B0); PG8_BAR; PG8_SCHED;
            PG8_STAGE(PG8_SB(0, 1), b2 + hstep, voffB);
            PG8_WAIT_V(6); PG8_BAR; PG8_MMA(1, 1, At, B1); PG8_BAR;
            PG8_LDB(B0, 1, 0); PG8_SCHED; PG8_LDA(At, 1, 0); PG8_STAGE(PG8_SA(0, 1), a2 + hstep, voffA);
            PG8_WAIT_L(8); PG8_BAR; PG8_WAIT_L(0); PG8_MMA(0, 0, At, B0); PG8_BAR; PG8_SCHED;
            PG8_LDB(B1, 1, 1); PG8_STAGE(PG8_SB(1, 0), b3, voffB);
            PG8_BAR; PG8_WAIT_L(0); PG8_MMA(0, 1, At, B1); PG8_BAR;
            PG8_LDA(At, 1, 1); PG8_STAGE(PG8_SA(1, 0), a3, voffA);
            PG8_BAR; PG8_WAIT_L(0); PG8_MMA(1, 0, At, B0); PG8_BAR; PG8_SCHED;
            PG8_STAGE(PG8_SB(1, 1), b3 + hstep, voffB);
            PG8_WAIT_V(6); PG8_BAR; PG8_MMA(1, 1, At, B1); PG8_BAR;
            }
        }
        if constexpr (ALIGN_EPI) { if (wr == 0) PG8_BAR; }
        if constexpr (!Epi::AFTER_DRAIN) { E(acc, cur, wr, wc, fr, fq); S.done(cur); }
        if (!has_next) break;
#pragma unroll
        for (int a = 0; a < 2; ++a)
#pragma unroll
            for (int b = 0; b < 2; ++b)
#pragma unroll
                for (int m = 0; m < 4; ++m)
#pragma unroll
                    for (int n = 0; n < 2; ++n) acc[a][b][m][n] = (f32x4){0.f, 0.f, 0.f, 0.f};
        cur = nxt; cA = nA; cB = nB; ++ui;
        if constexpr (ALIGN_EPI) { if (wr == 1) PG8_BAR; }
    }
    PG8_WAIT_V(0);
    if constexpr (!ALIGN_EPI) { if (wr == 0) PG8_BAR; }
    PG8_BAR;
    if constexpr (Epi::AFTER_DRAIN) { E.fused(acc, cur, wr, wc, fr, fq, lds, wid, lane); S.done(cur); }
#undef PG8_SA
#undef PG8_SB
#undef PG8_STAGE
#undef PG8_LDA
#undef PG8_LDB
#undef PG8_MMA
#undef PG8_WAIT_V
#undef PG8_WAIT_L
#undef PG8_BAR
#undef PG8_SCHED
}
}
#ifndef REP_D1
#define REP_D1 1
#endif
#ifndef REP_D2
#define REP_D2 1
#endif
#ifndef REP_D3
#define REP_D3 1
#endif

#define LAS __attribute__((address_space(3)))
typedef unsigned short bf16;
typedef float f32x4 __attribute__((ext_vector_type(4)));
typedef unsigned u32x4 __attribute__((ext_vector_type(4)));
typedef short bf16x8 __attribute__((ext_vector_type(8)));

constexpr int DM = 1024, NBATCH = 8, SEQ = 2048, SB = 8, ST = 32, PAST = 1024, FF = 4096;
constexpr int MP = NBATCH * SEQ, MS = SB * ST, MT = MP + MS;
constexpr int EVEN_IN = 2560, ODD_SRC = 2628, ODD_IN = 2816;
constexpr int EQ = 0, EK = 512, EV = 1024, EU = 1536, EVB = 2048;
constexpr int OQ = 0, OK = 512, OV = 640, OQI = 768, OKI = 1024, OWI = 1088, OGB = 1152, OGC = 1664, OHD = 2176;
constexpr float EPS = 1e-6f;
constexpr size_t OFF_YP = 0, OFF_YS = OFF_YP + (size_t)MP * DM, OFF_AKP = OFF_YS + (size_t)MS * DM, OFF_AVP = OFF_AKP + (size_t)2 * MP * 512,
    OFF_AKS = OFF_AVP + (size_t)2 * MP * 512, OFF_AVS = OFF_AKS + (size_t)2 * MS * 512, OFF_BVS = OFF_AVS + (size_t)2 * MS * 512,
    OFF_CKP = OFF_BVS + (size_t)2 * MS * 512, OFF_CVP = OFF_CKP + (size_t)2 * MP * 128, OFF_CIP = OFF_CVP + (size_t)2 * MP * 128,
    OFF_CKS = OFF_CIP + (size_t)2 * MP * 64, OFF_CVS = OFF_CKS + (size_t)2 * MS * 128, OFF_CIS = OFF_CVS + (size_t)2 * MS * 128,
    OFF_DCP = OFF_CIS + (size_t)2 * MS * 64, OFF_DCS = OFF_DCP + (size_t)2 * 8 * 2 * 512, OUT_TOTAL = OFF_DCS + (size_t)2 * 8 * 2 * 512;
static_assert(OUT_TOTAL == 62062592, "output size");
constexpr size_t MiB = 1u << 20;
constexpr size_t WS_WINE = 0, WS_WINO = 10 * MiB, WS_WOUT = 21 * MiB, WS_W1 = 29 * MiB, WS_W2 = 61 * MiB, WS_H = 93 * MiB, WS_ACT = 126 * MiB,
    WS_Z = 126 * MiB, WS_CAT = 216 * MiB, WS_END = 256 * MiB,
    WS_VTP = 256 * MiB  , WS_KS = 261 * MiB  , WS_VTS = 264 * MiB  ,
    WS_KIS = 267 * MiB  , WS_VTA = 269 * MiB  , WS_KSA = 286 * MiB  ,
    WS_VTSA = 295 * MiB  , WS_CTL = 304 * MiB  , WS_END2 = 305 * MiB;
constexpr int VTL = 2112;
constexpr size_t CTL_BYTES = 16384;
constexpr size_t WS_WSB = WS_CTL + 65536;
constexpr int LDS_BARST = 143360;
constexpr int SKL = 1088;
static_assert(WS_WINE + (size_t)2 * EVEN_IN * DM * 2 <= WS_WINO && WS_WINO + (size_t)2 * ODD_IN * DM * 2 <= WS_WOUT && WS_H + (size_t)MT * DM * 2 <= WS_ACT &&
              WS_Z + (size_t)MT * ODD_IN * 2 <= WS_CAT && WS_CAT + (size_t)MT * DM * 2 <= WS_END && WS_ACT + (size_t)MT * FF * 2 <= WS_END, "ws map");
constexpr int LDS_BYTES = 147456;

struct Args { const float* in[24]; float* out; unsigned char* ws; int ph_lo, ph_hi; };
static_assert(sizeof(Args) == 216 && offsetof(Args, out) == 192 && offsetof(Args, ws) == 200, "Args layout (re-read from the kernarg segment by offset)");

__device__ __forceinline__ float bf2f(unsigned v) { return __uint_as_float(v << 16); }
__device__ __forceinline__ unsigned f2bf(float f) { unsigned u = __float_as_uint(f); return (u + 0x7fffu + ((u >> 16) & 1u)) >> 16; }
__device__ __forceinline__ unsigned pk2(float lo, float hi) { return f2bf(lo) | (f2bf(hi) << 16); }
__device__ __forceinline__ void unpack8(const u32x4 r, float (&f)[8]) {
    f[0] = __uint_as_float(r.x << 16); f[1] = __uint_as_float(r.x & 0xffff0000u); f[2] = __uint_as_float(r.y << 16); f[3] = __uint_as_float(r.y & 0xffff0000u);
    f[4] = __uint_as_float(r.z << 16); f[5] = __uint_as_float(r.z & 0xffff0000u); f[6] = __uint_as_float(r.w << 16); f[7] = __uint_as_float(r.w & 0xffff0000u); }
__device__ __forceinline__ u32x4 pack8(const float (&f)[8]) { u32x4 o; o.x = pk2(f[0], f[1]); o.y = pk2(f[2], f[3]); o.z = pk2(f[4], f[5]); o.w = pk2(f[6], f[7]); return o; }
__device__ __forceinline__ float wave_sum(float v) {
#pragma unroll
    for (int o = 1; o < 64; o <<= 1) v += __shfl_xor(v, o);
    return v; }
__device__ __forceinline__ float wave_max(float v) {
#pragma unroll
    for (int o = 1; o < 64; o <<= 1) v = fmaxf(v, __shfl_xor(v, o));
    return v; }
__device__ __forceinline__ int wave_sum_i(int v) {
#pragma unroll
    for (int o = 1; o < 64; o <<= 1) v += __shfl_xor(v, o);
    return v; }
__device__ __forceinline__ int wave_count(int c) {
    c += __builtin_amdgcn_update_dpp(0, c, 0x111, 0xf, 0xf, true);
    c += __builtin_amdgcn_update_dpp(0, c, 0x112, 0xf, 0xf, true);
    c += __builtin_amdgcn_update_dpp(0, c, 0x114, 0xf, 0xf, true);
    c += __builtin_amdgcn_update_dpp(0, c, 0x118, 0xf, 0xf, true);
    return __builtin_amdgcn_readlane(c, 15) + __builtin_amdgcn_readlane(c, 31) + __builtin_amdgcn_readlane(c, 47) + __builtin_amdgcn_readlane(c, 63);
}
#define LDS_WAIT() asm volatile("s_waitcnt lgkmcnt(0)" ::: "memory")
__device__ __forceinline__ float gelu_tanh(float x) {
    const float u2 = -1.5957691216057308f * (x + 0.044715f * x * x * x); return x * __builtin_amdgcn_rcpf(1.f + __expf(u2)); }

__device__ __forceinline__ void transpose_item(const float* W, int K, int Nsrc, bf16* WT, int nblk, int mode, LAS float* scr, int item, int lane) {
    const int kb = item / nblk, nb = item % nblk, k0 = 64 * kb, n0 = 32 * nb;
    const int nd = n0 + (lane & 31);
    int src = nd;
    if (mode == 1) src = nd < 1092 ? nd : (nd < 1152 ? -1 : (nd < 2688 ? nd - 60 : -1));
#pragma unroll 8
    for (int i = 0; i < 32; ++i) { const int kk = 2 * i + (lane >> 5); scr[kk * 33 + (lane & 31)] = (src >= 0) ? W[(size_t)(k0 + kk) * Nsrc + src] : 0.f; }
    LDS_WAIT();
    const int c = lane & 7;
#pragma unroll
    for (int jn = 0; jn < 4; ++jn) { const int n = (lane >> 3) + 8 * jn; const LAS float* s = scr + (8 * c) * 33 + n;
        u32x4 o; o.x = pk2(s[0 * 33], s[1 * 33]); o.y = pk2(s[2 * 33], s[3 * 33]); o.z = pk2(s[4 * 33], s[5 * 33]); o.w = pk2(s[6 * 33], s[7 * 33]);
        *(u32x4*)(WT + (size_t)(n0 + n) * K + k0 + 8 * c) = o; }
    LDS_WAIT();
}
__device__ __forceinline__ void norm_row(const float* xrow, const float* g, bf16* orow, float* xcopy, int lane) {
    const f32x4* xr = (const f32x4*)xrow + lane; f32x4 v[4]; float s = 0.f;
#pragma unroll
    for (int q = 0; q < 4; ++q) { v[q] = xr[64 * q]; s += (v[q].x * v[q].x + v[q].y * v[q].y) + (v[q].z * v[q].z + v[q].w * v[q].w); }
    const float r = rsqrtf(wave_sum(s) * (1.f / 1024.f) + EPS);
    const f32x4* gr = (const f32x4*)g + lane;
    unsigned long long* o8 = (unsigned long long*)orow + lane;
#pragma unroll
    for (int q = 0; q < 4; ++q) { const f32x4 gg = gr[64 * q]; const f32x4 y = v[q] * r * gg;
        o8[64 * q] = (unsigned long long)pk2(y.x, y.y) | ((unsigned long long)pk2(y.z, y.w) << 32);
        if (xcopy) ((f32x4*)xcopy)[lane + 64 * q] = v[q]; }
}
__device__ __forceinline__ void p_prologue(const Args& a, LAS unsigned char* lds, int gw, int NGW, int wave, int lane) {
    unsigned char* ws = a.ws;
    LAS float* scr = (LAS float*)(lds + wave * 16384);
    constexpr int I_E = 16 * 80, I_O = 16 * 88, I_W = 16 * 32, I_1 = 16 * 128, I_2 = 64 * 32;
    constexpr int NITEMS = 2 * I_E + 2 * I_O + 4 * I_W + 4 * I_1 + 4 * I_2;
    for (int it = gw; it < NITEMS; it += NGW) {
        int r = it;
        if (r < 2 * I_E) { const int j = r / I_E; transpose_item(a.in[10] + (size_t)j * DM * EVEN_IN, DM, EVEN_IN, (bf16*)(ws + WS_WINE) + (size_t)j * EVEN_IN * DM, 80, 0, scr, r % I_E, lane); continue; } r -= 2 * I_E;
        if (r < 2 * I_O) { const int j = r / I_O; transpose_item(a.in[17] + (size_t)j * DM * ODD_SRC, DM, ODD_SRC, (bf16*)(ws + WS_WINO) + (size_t)j * ODD_IN * DM, 88, 1, scr, r % I_O, lane); continue; } r -= 2 * I_O;
        if (r < 4 * I_W) { const int li = r / I_W; const float* src = ((li & 1) ? a.in[21] : a.in[16]) + (size_t)(li >> 1) * DM * DM;
            transpose_item(src, DM, DM, (bf16*)(ws + WS_WOUT) + (size_t)li * DM * DM, 32, 0, scr, r % I_W, lane); continue; } r -= 4 * I_W;
        if (r < 4 * I_1) { const int li = r / I_1; transpose_item(a.in[22] + (size_t)li * DM * FF, DM, FF, (bf16*)(ws + WS_W1) + (size_t)li * FF * DM, 128, 0, scr, r % I_1, lane); continue; } r -= 4 * I_1;
        { const int li = r / I_2; transpose_item(a.in[23] + (size_t)li * FF * DM, FF, DM, (bf16*)(ws + WS_W2) + (size_t)li * DM * FF, 32, 0, scr, r % I_2, lane); }
    }
    {
        bf16* wsb = (bf16*)(ws + WS_WSB);
        for (int e = gw * 64 + lane; e < 2 * 4 * 128 * 128; e += NGW * 64) { const int p = (e >> 7) & 127, q = e & 127; wsb[e] = (bf16)f2bf(((q >> 6) <= (p >> 6)) ? a.in[14][e] : 0.f); }
    }
    bf16* H = (bf16*)(ws + WS_H);
    for (int m = gw; m < MT; m += NGW) { const float* src = m < MP ? a.in[0] + (size_t)m * DM : a.in[1] + (size_t)(m - MP) * DM;
        norm_row(src, a.in[8], H + (size_t)m * DM, a.out + (size_t)m * DM, lane); }
}
__device__ __forceinline__ void norm_row2(const float* x0, const float* x1, const float* g, bf16* o0, bf16* o1, int lane) {
    const f32x4* xr0 = (const f32x4*)x0 + lane; const f32x4* xr1 = (const f32x4*)x1 + lane; f32x4 v0[4], v1[4]; float s0 = 0.f, s1 = 0.f;
#pragma unroll
    for (int q = 0; q < 4; ++q) { v0[q] = xr0[64 * q]; v1[q] = xr1[64 * q]; }
#pragma unroll
    for (int q = 0; q < 4; ++q) { s0 += (v0[q].x * v0[q].x + v0[q].y * v0[q].y) + (v0[q].z * v0[q].z + v0[q].w * v0[q].w); s1 += (v1[q].x * v1[q].x + v1[q].y * v1[q].y) + (v1[q].z * v1[q].z + v1[q].w * v1[q].w); }
#pragma unroll
    for (int o = 1; o < 64; o <<= 1) { s0 += __shfl_xor(s0, o); s1 += __shfl_xor(s1, o); }
    const float r0 = rsqrtf(s0 * (1.f / 1024.f) + EPS), r1 = rsqrtf(s1 * (1.f / 1024.f) + EPS);
    const f32x4* gr = (const f32x4*)g + lane;
    unsigned long long* p0 = (unsigned long long*)o0 + lane; unsigned long long* p1 = (unsigned long long*)o1 + lane;
#pragma unroll
    for (int q = 0; q < 4; ++q) { const f32x4 gg = gr[64 * q]; const f32x4 y0 = v0[q] * r0 * gg, y1 = v1[q] * r1 * gg;
        p0[64 * q] = (unsigned long long)pk2(y0.x, y0.y) | ((unsigned long long)pk2(y0.z, y0.w) << 32);
        p1[64 * q] = (unsigned long long)pk2(y1.x, y1.y) | ((unsigned long long)pk2(y1.z, y1.w) << 32); }
}
__device__ __forceinline__ void p_norm(const Args& a, const float* g, int gw, int NGW, int lane) {
    bf16* H = (bf16*)(a.ws + WS_H);
    for (int m = 2 * gw; m < MT; m += 2 * NGW) norm_row2(a.out + (size_t)m * DM, a.out + (size_t)(m + 1) * DM, g, H + (size_t)m * DM, H + (size_t)(m + 1) * DM, lane);
}

__device__ __forceinline__ void store8f(float* p, const float (&f)[8]) {
    __builtin_nontemporal_store((f32x4){f[0], f[1], f[2], f[3]}, (f32x4*)p); __builtin_nontemporal_store((f32x4){f[4], f[5], f[6], f[7]}, (f32x4*)(p + 4)); }
struct EvRaw { u32x4 q, k, v, u, vb; };
__device__ __forceinline__ EvRaw even_load(const bf16* z, int lane) { EvRaw r; r.q = *(const u32x4*)(z + EQ + 8 * lane); r.k = *(const u32x4*)(z + EK + 8 * lane); r.v = *(const u32x4*)(z + EV + 8 * lane);
    r.u = *(const u32x4*)(z + EU + 8 * lane); r.vb = *(const u32x4*)(z + EVB + 8 * lane); return r; }
__device__ __forceinline__ void even_post_row(const Args& a, int j, int r, int lane, LAS bf16* vtl, bool to_lds, const EvRaw& raw) {
    bf16* z = (bf16*)(a.ws + WS_Z) + (size_t)r * EVEN_IN;
    const bool samp = r >= MP; const int rs = r - MP;
    const int d0 = (8 * lane) & 63;
    const u32x4 raw_q = raw.q, raw_k = raw.k, raw_v = raw.v, raw_u = raw.u, raw_vb = raw.vb;
    float gq8[8], gk8[8], gb8[8];
    { const float* p = a.in[11] + j * 64 + d0; const float* q = a.in[12] + j * 64 + d0; const float* s = a.in[13] + j * 512 + 8 * lane;
#pragma unroll
      for (int e = 0; e < 8; ++e) { gq8[e] = p[e]; gk8[e] = q[e]; gb8[e] = s[e]; } }
    float f[8];
    {
        unpack8(raw_q, f);
        float ss = 0.f;
#pragma unroll
        for (int e = 0; e < 8; ++e) ss += f[e] * f[e];
        ss += __shfl_xor(ss, 1); ss += __shfl_xor(ss, 2); ss += __shfl_xor(ss, 4);
        const float rn = rsqrtf(ss * (1.f / 64.f) + EPS);
#pragma unroll
        for (int e = 0; e < 8; ++e) f[e] = f[e] * rn * gq8[e];
        *(u32x4*)(z + EQ + 8 * lane) = pack8(f);
    }
    {
        unpack8(raw_k, f);
        float ss = 0.f;
#pragma unroll
        for (int e = 0; e < 8; ++e) ss += f[e] * f[e];
        ss += __shfl_xor(ss, 1); ss += __shfl_xor(ss, 2); ss += __shfl_xor(ss, 4);
        const float rn = rsqrtf(ss * (1.f / 64.f) + EPS);
#pragma unroll
        for (int e = 0; e < 8; ++e) f[e] = f[e] * rn * gk8[e];
        *(u32x4*)(z + EK + 8 * lane) = pack8(f);
        if (samp) *(u32x4*)((bf16*)(a.ws + WS_KSA) + ((size_t)(rs / ST) * SKL + PAST + (rs % ST)) * 512 + 8 * lane) = pack8(f);
        float* o = samp ? a.out + OFF_AKS + (size_t)j * MS * 512 + (size_t)rs * 512 : a.out + OFF_AKP + (size_t)j * MP * 512 + (size_t)r * 512;
        store8f(o + 8 * lane, f);
    }
    {
        unpack8(raw_v, f);
        float* o = samp ? a.out + OFF_AVS + (size_t)j * MS * 512 + (size_t)rs * 512 : a.out + OFF_AVP + (size_t)j * MP * 512 + (size_t)r * 512;
        store8f(o + 8 * lane, f);
        if (to_lds) *(LAS u32x4*)(vtl + 8 * lane) = pack8(f);
        else {
            const int hh = lane >> 3;
            bf16* vt; size_t vs;
            if (samp) { vs = SKL; vt = (bf16*)(a.ws + WS_VTSA) + ((size_t)((rs / ST) * 8 + hh) * 64 + d0) * SKL + PAST + (rs % ST); }
            else { vs = VTL; vt = (bf16*)(a.ws + WS_VTA) + ((size_t)((r / SEQ) * 8 + hh) * 64 + d0) * VTL + (r % SEQ); }
#pragma unroll
            for (int e = 0; e < 8; ++e) vt[(size_t)e * vs] = (bf16)f2bf(f[e]);
        }
    }
    {
        unpack8(raw_u, f);
#pragma unroll
        for (int e = 0; e < 8; ++e) f[e] = gelu_tanh(f[e]);
        *(u32x4*)(z + EU + 8 * lane) = pack8(f);
    }
    {
        unpack8(raw_vb, f);
        float ss = 0.f;
#pragma unroll
        for (int e = 0; e < 8; ++e) { f[e] = gelu_tanh(f[e]); ss += f[e] * f[e]; }
        const float rn = rsqrtf(wave_sum(ss) * (1.f / 512.f) + EPS);
#pragma unroll
        for (int e = 0; e < 8; ++e) f[e] = f[e] * rn * gb8[e];
        *(u32x4*)(z + EVB + 8 * lane) = pack8(f);
        if (samp) store8f(a.out + OFF_BVS + (size_t)j * MS * 512 + (size_t)rs * 512 + 8 * lane, f);
    }
}
__device__ __forceinline__ void cin8(const bf16* zrow, int lane, float (&c)[8]) {
    float gc[8], hd[8]; unpack8(*(const u32x4*)(zrow + OGC + 8 * lane), gc); unpack8(*(const u32x4*)(zrow + OHD + 8 * lane), hd);
#pragma unroll
    for (int e = 0; e < 8; ++e) c[e] = gc[e] * hd[e];
}
struct OdRaw { u32x4 q, gb; unsigned k, v, ki; float c2[8], c1[8], c0[8]; };
__device__ __forceinline__ void odd_load(const Args& a, int j, int r, int lane, OdRaw& R) {
    const bf16* z = (const bf16*)(a.ws + WS_Z) + (size_t)r * ODD_IN;
    const bool samp = r >= MP; const int rs = r - MP;
    const int b = samp ? rs / ST : r / SEQ, t = samp ? rs % ST : r % SEQ;
    R.q = *(const u32x4*)(z + OQ + 8 * lane); R.gb = *(const u32x4*)(z + OGB + 8 * lane);
    R.k = *(const unsigned*)(z + OK + 2 * lane); R.v = *(const unsigned*)(z + OV + 2 * lane); R.ki = z[OKI + lane];
    cin8(z, lane, R.c2);
    const float* prev = a.in[7] + ((size_t)(j * 8 + b) * 2) * 512 + 8 * lane;
    if (t >= 1) cin8(z - ODD_IN, lane, R.c1);
    else {
#pragma unroll
        for (int e = 0; e < 8; ++e) R.c1[e] = samp ? prev[512 + e] : 0.f; }
    if (t >= 2) cin8(z - 2 * ODD_IN, lane, R.c0);
    else {
#pragma unroll
        for (int e = 0; e < 8; ++e) R.c0[e] = samp ? prev[t * 512 + e] : 0.f; }
}
__device__ __forceinline__ void odd_post_row(const Args& a, int j, int r, int lane, LAS bf16* vtl, bool to_lds, const OdRaw& R) {
    bf16* Zb = (bf16*)(a.ws + WS_Z);
    bf16* z = Zb + (size_t)r * ODD_IN;
    const bool samp = r >= MP; const int rs = r - MP;
    const int b = samp ? rs / ST : r / SEQ, t = samp ? rs % ST : r % SEQ, T = samp ? ST : SEQ;
    const u32x4 raw_q = R.q, raw_gb = R.gb; const unsigned raw_k = R.k, raw_v = R.v, raw_ki = R.ki;
    float c2[8], c1[8], c0[8];
#pragma unroll
    for (int e = 0; e < 8; ++e) { c2[e] = R.c2[e]; c1[e] = R.c1[e]; c0[e] = R.c0[e]; }
    float gq8[8], cw24[24]; float gk0, gk1;
    { const float* p = a.in[18] + j * 64 + ((8 * lane) & 63); const float* q = a.in[19] + j * 64 + ((2 * lane) & 63); const float* cwp = a.in[20] + (size_t)j * 3 * 512 + 8 * lane;
      gk0 = q[0]; gk1 = q[1];
#pragma unroll
      for (int e = 0; e < 8; ++e) { gq8[e] = p[e]; cw24[e] = cwp[e]; cw24[8 + e] = cwp[512 + e]; cw24[16 + e] = cwp[1024 + e]; } }
    float f[8];
    {
        unpack8(raw_q, f);
        float ss = 0.f;
#pragma unroll
        for (int e = 0; e < 8; ++e) ss += f[e] * f[e];
        ss += __shfl_xor(ss, 1); ss += __shfl_xor(ss, 2); ss += __shfl_xor(ss, 4);
        const float rn = rsqrtf(ss * (1.f / 64.f) + EPS);
#pragma unroll
        for (int e = 0; e < 8; ++e) f[e] = f[e] * rn * gq8[e];
        *(u32x4*)(z + OQ + 8 * lane) = pack8(f);
    }
    {
        const unsigned raw = raw_k;
        float k0 = __uint_as_float(raw << 16), k1 = __uint_as_float(raw & 0xffff0000u);
        float ss = k0 * k0 + k1 * k1;
        ss += __shfl_xor(ss, 1); ss += __shfl_xor(ss, 2); ss += __shfl_xor(ss, 4); ss += __shfl_xor(ss, 8); ss += __shfl_xor(ss, 16);
        const float rn = rsqrtf(ss * (1.f / 64.f) + EPS);
        k0 = k0 * rn * gk0; k1 = k1 * rn * gk1;
        *(unsigned*)(z + OK + 2 * lane) = pk2(k0, k1);
        if (samp) *(unsigned*)((bf16*)(a.ws + WS_KS) + ((size_t)b * SKL + PAST + t) * 128 + 2 * lane) = pk2(k0, k1);
        float* o = samp ? a.out + OFF_CKS + (size_t)j * MS * 128 + (size_t)rs * 128 : a.out + OFF_CKP + (size_t)j * MP * 128 + (size_t)r * 128;
        o[2 * lane] = k0; o[2 * lane + 1] = k1;
    }
    {
        const unsigned raw = raw_v;
        float* o = samp ? a.out + OFF_CVS + (size_t)j * MS * 128 + (size_t)rs * 128 : a.out + OFF_CVP + (size_t)j * MP * 128 + (size_t)r * 128;
        o[2 * lane] = __uint_as_float(raw << 16); o[2 * lane + 1] = __uint_as_float(raw & 0xffff0000u);
        const int gg = lane >> 5, dd = (2 * lane) & 63;
        if (to_lds) *(LAS unsigned*)(vtl + 2 * lane) = raw;
        else if (samp) { bf16* vt = (bf16*)(a.ws + WS_VTS) + ((size_t)(b * 2 + gg) * 64 + dd) * SKL + PAST + t; vt[0] = (bf16)(raw & 0xffffu); vt[SKL] = (bf16)(raw >> 16); }
        else { bf16* vt = (bf16*)(a.ws + WS_VTP) + ((size_t)(b * 2 + gg) * 64 + dd) * VTL + t; vt[0] = (bf16)(raw & 0xffffu); vt[VTL] = (bf16)(raw >> 16); }
    }
    {
        float* o = samp ? a.out + OFF_CIS + (size_t)j * MS * 64 + (size_t)rs * 64 : a.out + OFF_CIP + (size_t)j * MP * 64 + (size_t)r * 64;
        o[lane] = bf2f(raw_ki);
        if (samp) ((bf16*)(a.ws + WS_KIS))[((size_t)b * SKL + PAST + t) * 64 + lane] = (bf16)raw_ki;
    }
    {
        float gb[8];
        unpack8(raw_gb, gb);
#pragma unroll
        for (int e = 0; e < 8; ++e) f[e] = gb[e] * (cw24[e] * c0[e] + cw24[8 + e] * c1[e] + cw24[16 + e] * c2[e]);
        *(u32x4*)((bf16*)(a.ws + WS_CAT) + (size_t)r * DM + 512 + 8 * lane) = pack8(f);
        if (t >= T - 2) { const int slot = t - (T - 2);
            float* o = (samp ? a.out + OFF_DCS : a.out + OFF_DCP) + ((size_t)(j * 8 + b) * 2 + slot) * 512 + 8 * lane;
            store8f(o, c2); }
    }
}

__device__ __forceinline__ void sb_item(const Args& a, int j, int item, LAS unsigned char* lds, int tid, int w, int lane) {
    int b, h, zq_row0, nq, qpos0, P, zk_row0, kend;
    if (item < 2048) { b = item >> 8; h = (item >> 5) & 7; const int qt = item & 31; zq_row0 = b * SEQ + qt * 64; nq = 64; qpos0 = qt * 64; P = 0; zk_row0 = b * SEQ; kend = qpos0 + 64; }
    else { const int s = item - 2048; b = s >> 3; h = s & 7; zq_row0 = MP + b * ST; nq = ST; qpos0 = PAST; P = PAST; zk_row0 = MP + b * ST; kend = PAST + ST; }
    const bf16* Z = (const bf16*)(a.ws + WS_Z);
    LAS float* Qs = (LAS float*)lds;
    LAS float* Ks = Qs + 64 * 68;
    LAS float* Vs = Ks + 64 * 68;
    LAS float* Wm = Vs + 64 * 64;
    LAS int* flags = (LAS int*)(Wm + 64 * 64);
    __syncthreads();
    {
        const int qi = tid >> 3, dd = (tid & 7) * 8; float f[8];
        if (qi < nq) { unpack8(*(const u32x4*)(Z + (size_t)(zq_row0 + qi) * EVEN_IN + EQ + h * 64 + dd), f);
#pragma unroll
            for (int e = 0; e < 8; ++e) f[e] *= 0.125f; }
        else {
#pragma unroll
            for (int e = 0; e < 8; ++e) f[e] = 0.f; }
        *(LAS f32x4*)(Qs + qi * 68 + dd) = (f32x4){f[0], f[1], f[2], f[3]}; *(LAS f32x4*)(Qs + qi * 68 + dd + 4) = (f32x4){f[4], f[5], f[6], f[7]};
    }
    float carry[8], o[8];
#pragma unroll
    for (int i = 0; i < 8; ++i) { carry[i] = 0.f; o[i] = 0.f; }
    const int kt_hi = (kend - 1) >> 6;
    const float* cak = a.in[2]; const float* cav = a.in[3];
    for (int kt = kt_hi; kt >= 0; --kt) {
        __syncthreads();
        if (kt != kt_hi) { int all = 1;
#pragma unroll
            for (int x = 0; x < 8; ++x) all &= flags[x];
            if (all) break; }
        {
            const int key = tid >> 3, dd = (tid & 7) * 8, p = kt * 64 + key; float kf[8], vf[8];
            if (p < P) { const size_t off = (((size_t)(j * 8 + b) * PAST + p) * 8 + h) * 64 + dd;
                const f32x4 k0 = *(const f32x4*)(cak + off), k1 = *(const f32x4*)(cak + off + 4), v0 = *(const f32x4*)(cav + off), v1 = *(const f32x4*)(cav + off + 4);
                kf[0] = k0.x; kf[1] = k0.y; kf[2] = k0.z; kf[3] = k0.w; kf[4] = k1.x; kf[5] = k1.y; kf[6] = k1.z; kf[7] = k1.w;
                vf[0] = v0.x; vf[1] = v0.y; vf[2] = v0.z; vf[3] = v0.w; vf[4] = v1.x; vf[5] = v1.y; vf[6] = v1.z; vf[7] = v1.w; }
            else if (p < kend) { const bf16* zr = Z + (size_t)(zk_row0 + p - P) * EVEN_IN + h * 64 + dd;
                unpack8(*(const u32x4*)(zr + EK), kf); unpack8(*(const u32x4*)(zr + EV), vf); }
            else {
#pragma unroll
                for (int e = 0; e < 8; ++e) { kf[e] = 0.f; vf[e] = 0.f; } }
            *(LAS f32x4*)(Ks + key * 68 + dd) = (f32x4){kf[0], kf[1], kf[2], kf[3]}; *(LAS f32x4*)(Ks + key * 68 + dd + 4) = (f32x4){kf[4], kf[5], kf[6], kf[7]};
            *(LAS f32x4*)(Vs + key * 64 + dd) = (f32x4){vf[0], vf[1], vf[2], vf[3]}; *(LAS f32x4*)(Vs + key * 64 + dd + 4) = (f32x4){vf[4], vf[5], vf[6], vf[7]};
        }
        __syncthreads();
        float zz[8];
#pragma unroll
        for (int i = 0; i < 8; ++i) zz[i] = 0.f;
#pragma unroll 4
        for (int dq = 0; dq < 16; ++dq) { const f32x4 kv = *(const LAS f32x4*)(Ks + lane * 68 + 4 * dq);
#pragma unroll
            for (int i = 0; i < 8; ++i) { const f32x4 qv = *(const LAS f32x4*)(Qs + (w * 8 + i) * 68 + 4 * dq); zz[i] += (qv.x * kv.x + qv.y * kv.y) + (qv.z * kv.z + qv.w * kv.w); } }
        const int s = kt * 64 + lane;
#pragma unroll
        for (int i = 0; i < 8; ++i) {
            const int t = qpos0 + w * 8 + i; const bool valid = s < t; const float zv = zz[i];
            const float sp = fmaxf(zv, 0.f) + log1pf(expf(-fabsf(zv)));
            const float ls = valid ? -sp : 0.f;
            float v = ls;
#pragma unroll
            for (int off = 1; off < 64; off <<= 1) { const float t2 = __shfl_down(v, off); if (lane + off < 64) v += t2; }
            const float after = carry[i] + (v - ls);
            carry[i] += __shfl(v, 0);
            const float wgt = valid ? expf((zv - sp) + after) : 0.f;
            Wm[(w * 8 + i) * 64 + lane] = wgt;
        }
        LDS_WAIT();
#pragma unroll 2
        for (int s4 = 0; s4 < 16; ++s4) {
            const float v0 = Vs[(4 * s4 + 0) * 64 + lane], v1 = Vs[(4 * s4 + 1) * 64 + lane], v2 = Vs[(4 * s4 + 2) * 64 + lane], v3 = Vs[(4 * s4 + 3) * 64 + lane];
#pragma unroll
            for (int i = 0; i < 8; ++i) { const f32x4 wv = *(const LAS f32x4*)(Wm + (w * 8 + i) * 64 + 4 * s4); o[i] += (wv.x * v0 + wv.y * v1) + (wv.z * v2 + wv.w * v3); } }
        float mx = -1e30f;
#pragma unroll
        for (int i = 0; i < 8; ++i) if (w * 8 + i < nq) mx = fmaxf(mx, carry[i]);
        if (lane == 0) flags[w] = (mx < -110.f) ? 1 : 0;
    }
    bf16* CAT = (bf16*)(a.ws + WS_CAT);
#pragma unroll
    for (int i = 0; i < 8; ++i) { const int qi = w * 8 + i; if (qi < nq) CAT[(size_t)(zq_row0 + qi) * DM + h * 64 + lane] = (bf16)f2bf(o[i]); }
}
__device__ __forceinline__ void cache_a_row(const Args& a, int j, int bp, int lane, LAS bf16* vtl) {
    const int b = bp >> 10, p = bp & 1023;
    const float* ck = a.in[2] + ((size_t)(j * 8 + b) * PAST + p) * 512 + 8 * lane; const float* cv = a.in[3] + ((size_t)(j * 8 + b) * PAST + p) * 512 + 8 * lane;
    const f32x4 k0 = *(const f32x4*)ck, k1 = *(const f32x4*)(ck + 4), v0 = *(const f32x4*)cv, v1 = *(const f32x4*)(cv + 4);
    u32x4 pk; pk.x = pk2(k0.x, k0.y); pk.y = pk2(k0.z, k0.w); pk.z = pk2(k1.x, k1.y); pk.w = pk2(k1.z, k1.w);
    *(u32x4*)((bf16*)(a.ws + WS_KSA) + ((size_t)b * SKL + p) * 512 + 8 * lane) = pk;
    u32x4 pv; pv.x = pk2(v0.x, v0.y); pv.y = pk2(v0.z, v0.w); pv.z = pk2(v1.x, v1.y); pv.w = pk2(v1.z, v1.w);
    *(LAS u32x4*)(vtl + 8 * lane) = pv;
}
struct SbSrc { const bf16* kb; int ks; const bf16* vt; int vts; };
__device__ __forceinline__ void sb2_tile(const f32x4 z, int base, int t, int quad, float& carry, float (&wout)[4]) {
    float ls[4], lz[4]; bool valid[4];
#pragma unroll
    for (int jj = 0; jj < 4; ++jj) { const int key = base + quad * 4 + jj; valid[jj] = (key < t) && (key >= 0);
        const float zv = z[jj] * 0.125f; const float sp = fmaxf(zv, 0.f) + __logf(1.f + __expf(-fabsf(zv)));
        ls[jj] = valid[jj] ? -sp : 0.f; lz[jj] = zv - sp; }
    const float e3 = 0.f, e2 = ls[3], e1 = e2 + ls[2], e0 = e1 + ls[1], T = e0 + ls[0];
    const float t1 = __shfl_xor(T, 16), t2 = __shfl_xor(T, 32), t3 = __shfl_xor(T, 48);
    const float H = (((quad ^ 1) > quad) ? t1 : 0.f) + (((quad ^ 2) > quad) ? t2 : 0.f) + (((quad ^ 3) > quad) ? t3 : 0.f);
    const float ba = carry + H;
    wout[0] = valid[0] ? __expf(lz[0] + ba + e0) : 0.f; wout[1] = valid[1] ? __expf(lz[1] + ba + e1) : 0.f;
    wout[2] = valid[2] ? __expf(lz[2] + ba + e2) : 0.f; wout[3] = valid[3] ? __expf(lz[3] + ba + e3) : 0.f;
    carry += (T + t1) + (t2 + t3);
}
__device__ __forceinline__ void sb2_wave_item(const Args& a, const SbSrc src, int zq_row0, int hcol, int qpos0, int lane) {
    const bf16* Z = (const bf16*)(a.ws + WS_Z);
    const int n = lane & 15, quad = lane >> 4;
    const bf16* zr = Z + (size_t)(zq_row0 + n) * EVEN_IN + EQ + hcol + quad * 8;
    const bf16x8 bq0 = *(const bf16x8*)zr, bq1 = *(const bf16x8*)(zr + 32);
    const int t = qpos0 + n;
    float carry = 0.f;
    f32x4 oacc[4];
#pragma unroll
    for (int mt = 0; mt < 4; ++mt) oacc[mt] = (f32x4){0.f, 0.f, 0.f, 0.f};
    const bf16* vbase = src.vt + (size_t)n * src.vts + quad * 4;
    const bf16* kbase = src.kb + (size_t)n * src.ks + quad * 8;
    bf16x8 ak[4]; unsigned long long vv[8];
#define SB_LOAD(AK, VV, ub_) do { const int lbc_ = (ub_) - 16 < 0 ? 0 : (ub_) - 16; const bf16* kup = kbase + (size_t)(ub_) * src.ks; const bf16* klp = kbase + (size_t)lbc_ * src.ks; \
        AK[0] = *(const bf16x8*)kup; AK[1] = *(const bf16x8*)(kup + 32); AK[2] = *(const bf16x8*)klp; AK[3] = *(const bf16x8*)(klp + 32); \
        _Pragma("unroll") for (int mt = 0; mt < 4; ++mt) { const bf16* vp = vbase + (size_t)(16 * mt) * src.vts; VV[2 * mt] = *(const unsigned long long*)(vp + lbc_); VV[2 * mt + 1] = *(const unsigned long long*)(vp + (ub_)); } } while (0)
    SB_LOAD(ak, vv, qpos0);
#pragma unroll 1
    for (int ub = qpos0; ub >= 0; ub -= 32) {
        const int lb = ub - 16;
        bf16x8 akn[4]; unsigned long long vvn[8];
        { const int ubn = ub >= 32 ? ub - 32 : 0; SB_LOAD(akn, vvn, ubn); }
        f32x4 zu = (f32x4){0.f, 0.f, 0.f, 0.f}, zl = (f32x4){0.f, 0.f, 0.f, 0.f};
        zu = __builtin_amdgcn_mfma_f32_16x16x32_bf16(ak[0], bq0, zu, 0, 0, 0); zu = __builtin_amdgcn_mfma_f32_16x16x32_bf16(ak[1], bq1, zu, 0, 0, 0);
        zl = __builtin_amdgcn_mfma_f32_16x16x32_bf16(ak[2], bq0, zl, 0, 0, 0); zl = __builtin_amdgcn_mfma_f32_16x16x32_bf16(ak[3], bq1, zl, 0, 0, 0);
        float wu[4], wl[4];
        sb2_tile(zu, ub, t, quad, carry, wu);
        sb2_tile(zl, lb, t, quad, carry, wl);
        u32x4 pk; pk.x = pg8::cvt_pk_bf16(wl[0], wl[1]); pk.y = pg8::cvt_pk_bf16(wl[2], wl[3]); pk.z = pg8::cvt_pk_bf16(wu[0], wu[1]); pk.w = pg8::cvt_pk_bf16(wu[2], wu[3]);
        const bf16x8 pb = __builtin_bit_cast(bf16x8, pk);
#pragma unroll
        for (int mt = 0; mt < 4; ++mt) { const unsigned long long lo = vv[2 * mt], hi = vv[2 * mt + 1];
            u32x4 vk; vk.x = (unsigned)lo; vk.y = (unsigned)(lo >> 32); vk.z = (unsigned)hi; vk.w = (unsigned)(hi >> 32);
            oacc[mt] = __builtin_amdgcn_mfma_f32_16x16x32_bf16(__builtin_bit_cast(bf16x8, vk), pb, oacc[mt], 0, 0, 0); }
        if (__all(carry < -110.f)) break;
#pragma unroll
        for (int x = 0; x < 4; ++x) ak[x] = akn[x];
#pragma unroll
        for (int x = 0; x < 8; ++x) vv[x] = vvn[x];
    }
#undef SB_LOAD
    bf16* orow = (bf16*)(a.ws + WS_CAT) + (size_t)(zq_row0 + n) * DM + hcol + quad * 4;
#pragma unroll
    for (int mt = 0; mt < 4; ++mt) *(unsigned long long*)(orow + 16 * mt) = (unsigned long long)pk2(oacc[mt].x, oacc[mt].y) | ((unsigned long long)pk2(oacc[mt].z, oacc[mt].w) << 32);
}
__device__ __forceinline__ void gate_item(const Args& a, int j, int item, LAS unsigned char* lds, int tid) {
    int b, g, P, row0;
    if (item < 512) { b = item >> 6; const int n = (item >> 2) & 15; g = item & 3; P = 128; row0 = b * SEQ + n * 128; }
    else { const int s = item - 512; b = s >> 2; g = s & 3; P = ST; row0 = MP + b * ST; }
    bf16* Z = (bf16*)(a.ws + WS_Z);
    LAS float* Wt = (LAS float*)lds;
    LAS float* VB = Wt + 128 * 128;
    __syncthreads();
    const float* wsb = a.in[14] + (size_t)(j * 4 + g) * 128 * 128;
    for (int e = tid; e < 128 * 32; e += 512) { const int p = e >> 5, q4 = (e & 31) * 4; const f32x4 wv = *(const f32x4*)(wsb + p * 128 + q4);
#pragma unroll
        for (int k = 0; k < 4; ++k) { const int q = q4 + k; Wt[q * 128 + p] = ((q >> 6) <= (p >> 6)) ? wv[k] : 0.f; } }
    for (int e = tid; e < 128 * 16; e += 512) { const int q = e >> 4, c8 = (e & 15) * 8;
        if (q < P) { float f[8]; unpack8(*(const u32x4*)(Z + (size_t)(row0 + q) * EVEN_IN + EVB + g * 128 + c8), f);
            *(LAS f32x4*)(VB + q * 128 + c8) = (f32x4){f[0], f[1], f[2], f[3]}; *(LAS f32x4*)(VB + q * 128 + c8 + 4) = (f32x4){f[4], f[5], f[6], f[7]}; } }
    __syncthreads();
    const int p0 = (tid >> 4) * 4, c0 = (tid & 15) * 8;
    if (p0 < P) {
        float acc[4][8];
#pragma unroll
        for (int x = 0; x < 4; ++x)
#pragma unroll
            for (int y = 0; y < 8; ++y) acc[x][y] = 0.f;
#pragma unroll 4
        for (int q = 0; q < P; ++q) { const f32x4 wv = *(const LAS f32x4*)(Wt + q * 128 + p0), v0 = *(const LAS f32x4*)(VB + q * 128 + c0), v1 = *(const LAS f32x4*)(VB + q * 128 + c0 + 4);
#pragma unroll
            for (int x = 0; x < 4; ++x) { acc[x][0] += wv[x] * v0.x; acc[x][1] += wv[x] * v0.y; acc[x][2] += wv[x] * v0.z; acc[x][3] += wv[x] * v0.w;
                acc[x][4] += wv[x] * v1.x; acc[x][5] += wv[x] * v1.y; acc[x][6] += wv[x] * v1.z; acc[x][7] += wv[x] * v1.w; } }
        bf16* CAT = (bf16*)(a.ws + WS_CAT);
#pragma unroll
        for (int x = 0; x < 4; ++x) { const int p = p0 + x; const float bias = a.in[15][(j * 4 + g) * 128 + p]; const size_t row = (size_t)(row0 + p);
            float u[8], f[8]; unpack8(*(const u32x4*)(Z + row * EVEN_IN + EU + g * 128 + c0), u);
#pragma unroll
            for (int y = 0; y < 8; ++y) f[y] = u[y] * (acc[x][y] + bias);
            *(u32x4*)(CAT + row * DM + 512 + g * 128 + c0) = pack8(f); }
    }
}
__device__ __forceinline__ void cache_c_row(const Args& a, int j, int bp, int lane, LAS bf16* vtl) {
    const int b = bp >> 10, p = bp & 1023;
    const float* ck = a.in[4] + ((size_t)(j * 8 + b) * PAST + p) * 128; const float* cv = a.in[5] + ((size_t)(j * 8 + b) * PAST + p) * 128;
    const float* ci = a.in[6] + ((size_t)(j * 8 + b) * PAST + p) * 64;
    *(unsigned*)((bf16*)(a.ws + WS_KS) + ((size_t)b * SKL + p) * 128 + 2 * lane) = pk2(ck[2 * lane], ck[2 * lane + 1]);
    *(LAS unsigned*)(vtl + 2 * lane) = pk2(cv[2 * lane], cv[2 * lane + 1]);
    ((bf16*)(a.ws + WS_KIS))[((size_t)b * SKL + p) * 64 + lane] = (bf16)f2bf(ci[lane]);
}
template <int NR> __device__ __forceinline__ void dsa_select(const LAS float* Srow, int L, int lane2, LAS unsigned long long* bmk) {
    unsigned u[NR];
#pragma unroll
    for (int i = 0; i < NR; ++i) { const int key = lane2 + 64 * i; unsigned x = 0u;
        if (key < L) { const unsigned bits = __float_as_uint(Srow[key]); x = (bits & 0x80000000u) ? ~bits : (bits | 0x80000000u); }
        u[i] = x; }
    unsigned thr = 0u; int need = 0;
    if (L > 256) {
        bool exact = false;
        for (int bit = 31; bit >= 0; --bit) { const unsigned cand = thr | (1u << bit); int c = 0;
#pragma unroll
            for (int i = 0; i < NR; ++i) c += (u[i] >= cand) ? 1 : 0;
            c = wave_count(c);
            if (c >= 256) thr = cand;
            if (c == 256) { exact = true; break; } }
        if (exact) { thr -= 1u; need = 0; }
        else { int cgt = 0;
#pragma unroll
            for (int i = 0; i < NR; ++i) cgt += (u[i] > thr) ? 1 : 0;
            need = 256 - wave_count(cgt); }
    }
    const unsigned long long lt = (1ull << lane2) - 1ull;
    int tie_seen = 0;
#pragma unroll
    for (int i = 0; i < NR; ++i) {
        const bool gt = u[i] > thr, eq = (u[i] == thr) && (need > 0);
        const unsigned long long beq = __ballot(eq); const int rank = tie_seen + __popcll(beq & lt); tie_seen += __popcll(beq);
        const bool sel = gt || (eq && rank < need);
        const unsigned long long bs = __ballot(sel);
        if (lane2 == 0) bmk[i] = bs; }
}
struct DsaSrc { const bf16* kb; int ks; const bf16* kib; int kis; const bf16* vt; int vts; };
__device__ __forceinline__ void dsa2_item(const Args& a, const DsaSrc src, int zq_row0, int L, LAS unsigned char* lds, int w, int lane) {
    const bf16* Z = (const bf16*)(a.ws + WS_Z);
    constexpr int SSTR = 2048;
    LAS float* S = (LAS float*)lds;
    LAS unsigned long long* BMK = (LAS unsigned long long*)(lds + 131072);
    const int n = lane & 15, quad = lane >> 4, hn = n & 3;
#pragma unroll 1
    for (int r = 0; r < 2; ++r) {
        __syncthreads();
        {
            bf16x8 bq[4][2]; float wsc[4];
#pragma unroll
            for (int nt = 0; nt < 4; ++nt) { const bf16* zr = Z + (size_t)(zq_row0 + r * 16 + nt * 4 + (n >> 2)) * ODD_IN;
#pragma unroll
                for (int kk = 0; kk < 2; ++kk) bq[nt][kk] = *(const bf16x8*)(zr + OQI + hn * 64 + kk * 32 + quad * 8);
                wsc[nt] = bf2f(zr[OWI + hn]) * 0.0625f; }
            const int ntile = L >> 4;
            bf16x8 af0, af1;
            if (w < ntile) { const bf16* kr = src.kib + (size_t)(w * 16 + n) * src.kis + quad * 8; af0 = *(const bf16x8*)kr; af1 = *(const bf16x8*)(kr + 32); }
            for (int kt = w; kt < ntile; kt += 8) {
                const int ktn = (kt + 8 < ntile) ? kt + 8 : kt;
                const bf16* krn = src.kib + (size_t)(ktn * 16 + n) * src.kis + quad * 8;
                const bf16x8 an0 = *(const bf16x8*)krn, an1 = *(const bf16x8*)(krn + 32);
#pragma unroll
                for (int nt = 0; nt < 4; ++nt) { f32x4 acc = (f32x4){0.f, 0.f, 0.f, 0.f};
                    acc = __builtin_amdgcn_mfma_f32_16x16x32_bf16(af0, bq[nt][0], acc, 0, 0, 0);
                    acc = __builtin_amdgcn_mfma_f32_16x16x32_bf16(af1, bq[nt][1], acc, 0, 0, 0);
#pragma unroll
                    for (int jj = 0; jj < 4; ++jj) { float v = fmaxf(acc[jj], 0.f) * wsc[nt]; v += __shfl_xor(v, 1); v += __shfl_xor(v, 2); acc[jj] = v; }
                    if (hn == 0) *(LAS f32x4*)(S + (nt * 4 + (n >> 2)) * SSTR + kt * 16 + quad * 4) = acc; }
                af0 = an0; af1 = an1;
            }
        }
        __syncthreads();
        int lane2 = lane; asm volatile("" : "+v"(lane2));
#pragma unroll 1
        for (int qq = 0; qq < 2; ++qq) { const int ql = 2 * w + qq;
            if (L <= 512) dsa_select<8>(S + ql * SSTR, L, lane2, BMK + (r * 16 + ql) * 32);
            else if (L <= 1024) dsa_select<16>(S + ql * SSTR, L, lane2, BMK + (r * 16 + ql) * 32);
            else if (L <= 1536) dsa_select<24>(S + ql * SSTR, L, lane2, BMK + (r * 16 + ql) * 32);
            else dsa_select<32>(S + ql * SSTR, L, lane2, BMK + (r * 16 + ql) * 32);
        }
    }
    __syncthreads();
    for (int rep3_ = 0; rep3_ < REP_D3; ++rep3_)
    {
        int lane3 = lane; asm volatile("" : "+v"(lane3));
        const int n = lane3 & 15, quad = lane3 >> 4, hn = n & 3, lane_r = lane3;
        const int g = w >> 2, qh = (w >> 1) & 1, kh = w & 1;
        bf16x8 bqk[4][2];
#pragma unroll
        for (int nt = 0; nt < 4; ++nt) { const bf16* zr = Z + (size_t)(zq_row0 + 16 * qh + 4 * nt + (n >> 2)) * ODD_IN + OQ + (4 * g + hn) * 64 + quad * 8;
            bqk[nt][0] = *(const bf16x8*)zr; bqk[nt][1] = *(const bf16x8*)(zr + 32); }
        f32x4 oacc[4][4]; float lsum[4];
#pragma unroll
        for (int nt = 0; nt < 4; ++nt) { lsum[nt] = 0.f;
#pragma unroll
            for (int mt = 0; mt < 4; ++mt) oacc[mt][nt] = (f32x4){0.f, 0.f, 0.f, 0.f}; }
        const int n32 = L >> 5, smid = (n32 + 1) >> 1, s_begin = kh ? smid : 0, s_end = kh ? n32 : smid;
        const bf16* kbase = src.kb + (size_t)n * src.ks + g * 64 + quad * 8;
        const bf16* vbase = src.vt + (size_t)(g * 64 + n) * src.vts + quad * 4;
        bf16x8 ak[4];
#define DSA_LOADK(AK, s_) do { const bf16* k0p = kbase + (size_t)((s_) * 32) * src.ks; const bf16* k1p = k0p + (size_t)16 * src.ks; \
            AK[0] = *(const bf16x8*)k0p; AK[1] = *(const bf16x8*)(k0p + 32); AK[2] = *(const bf16x8*)k1p; AK[3] = *(const bf16x8*)(k1p + 32); } while (0)
        if (s_begin < s_end) DSA_LOADK(ak, s_begin);
#pragma unroll 1
        for (int s = s_begin; s < s_end; ++s) {
            unsigned long long vv[8];
#pragma unroll
            for (int mt = 0; mt < 4; ++mt) { const bf16* vp = vbase + (size_t)(16 * mt) * src.vts + s * 32; vv[2 * mt] = *(const unsigned long long*)vp; vv[2 * mt + 1] = *(const unsigned long long*)(vp + 16); }
            bf16x8 akn[4];
            { const int sn = (s + 1 < s_end) ? s + 1 : s; DSA_LOADK(akn, sn); }
            bf16x8 av[4];
#pragma unroll
            for (int mt = 0; mt < 4; ++mt) { u32x4 pk; pk.x = (unsigned)vv[2 * mt]; pk.y = (unsigned)(vv[2 * mt] >> 32); pk.z = (unsigned)vv[2 * mt + 1]; pk.w = (unsigned)(vv[2 * mt + 1] >> 32); av[mt] = __builtin_bit_cast(bf16x8, pk); }
#pragma unroll
            for (int nt = 0; nt < 4; ++nt) {
                f32x4 s0 = (f32x4){0.f, 0.f, 0.f, 0.f}, s1 = (f32x4){0.f, 0.f, 0.f, 0.f};
                s0 = __builtin_amdgcn_mfma_f32_16x16x32_bf16(ak[0], bqk[nt][0], s0, 0, 0, 0); s0 = __builtin_amdgcn_mfma_f32_16x16x32_bf16(ak[1], bqk[nt][1], s0, 0, 0, 0);
                s1 = __builtin_amdgcn_mfma_f32_16x16x32_bf16(ak[2], bqk[nt][0], s1, 0, 0, 0); s1 = __builtin_amdgcn_mfma_f32_16x16x32_bf16(ak[3], bqk[nt][1], s1, 0, 0, 0);
                const unsigned long long word = BMK[(16 * qh + 4 * nt + (n >> 2)) * 32 + (s >> 1)];
                const unsigned half = (unsigned)(word >> ((s & 1) * 32));
                const unsigned b0 = (half >> (quad * 4)) & 0xFu, b1 = (half >> (16 + quad * 4)) & 0xFu;
                float p0[4], p1[4];
#pragma unroll
                for (int jj = 0; jj < 4; ++jj) {
                    p0[jj] = ((b0 >> jj) & 1u) ? __builtin_amdgcn_exp2f(fminf(s0[jj] * 0.18033688f, 86.f)) : 0.f;
                    p1[jj] = ((b1 >> jj) & 1u) ? __builtin_amdgcn_exp2f(fminf(s1[jj] * 0.18033688f, 86.f)) : 0.f; }
                lsum[nt] += ((p0[0] + p0[1]) + (p0[2] + p0[3])) + ((p1[0] + p1[1]) + (p1[2] + p1[3]));
                u32x4 pk; pk.x = pg8::cvt_pk_bf16(p0[0], p0[1]); pk.y = pg8::cvt_pk_bf16(p0[2], p0[3]); pk.z = pg8::cvt_pk_bf16(p1[0], p1[1]); pk.w = pg8::cvt_pk_bf16(p1[2], p1[3]);
                const bf16x8 pb = __builtin_bit_cast(bf16x8, pk);
#pragma unroll
                for (int mt = 0; mt < 4; ++mt) oacc[mt][nt] = __builtin_amdgcn_mfma_f32_16x16x32_bf16(av[mt], pb, oacc[mt][nt], 0, 0, 0);
            }
#pragma unroll
            for (int x = 0; x < 4; ++x) ak[x] = akn[x];
        }
#undef DSA_LOADK
        LAS float* RED = (LAS float*)lds + (size_t)(w >> 1) * (68 * 64);
        if (kh == 1) {
#pragma unroll
            for (int mt = 0; mt < 4; ++mt)
#pragma unroll
                for (int nt = 0; nt < 4; ++nt)
#pragma unroll
                    for (int e = 0; e < 4; ++e) RED[((mt * 4 + nt) * 4 + e) * 64 + lane_r] = oacc[mt][nt][e];
#pragma unroll
            for (int nt = 0; nt < 4; ++nt) RED[(64 + nt) * 64 + lane_r] = lsum[nt];
        }
        __syncthreads();
        if (kh == 0) {
            bf16* CAT = (bf16*)(a.ws + WS_CAT);
#pragma unroll
            for (int nt = 0; nt < 4; ++nt) { float l = lsum[nt] + RED[(64 + nt) * 64 + lane_r]; l += __shfl_xor(l, 16); l += __shfl_xor(l, 32); const float inv = 1.f / l;
                bf16* orow = CAT + (size_t)(zq_row0 + 16 * qh + 4 * nt + (n >> 2)) * DM + (4 * g + hn) * 64 + quad * 4;
#pragma unroll
                for (int mt = 0; mt < 4; ++mt) { f32x4 o = oacc[mt][nt];
#pragma unroll
                    for (int e = 0; e < 4; ++e) o[e] = (o[e] + RED[((mt * 4 + nt) * 4 + e) * 64 + lane_r]) * inv;
                    *(unsigned long long*)(orow + 16 * mt) = (unsigned long long)pk2(o.x, o.y) | ((unsigned long long)pk2(o.z, o.w) << 32); } }
        }
    }
}
__device__ __forceinline__ void gate2_item(const Args& a, int j, int item, LAS unsigned char* lds, int tid, int w, int lane) {
    int b, g, P, row0;
    if (item < 512) { b = item >> 6; const int nn = (item >> 2) & 15; g = item & 3; P = 128; row0 = b * SEQ + nn * 128; }
    else { const int s = item - 512; b = s >> 2; g = s & 3; P = ST; row0 = MP + b * ST; }
    const bf16* Z = (const bf16*)(a.ws + WS_Z);
    constexpr int VP = 136;
    LAS bf16* VB = (LAS bf16*)lds;
    __syncthreads();
    for (int e = tid; e < P * 16; e += 512) { const int q = e >> 4, c8 = (e & 15) * 8;
        *(LAS u32x4*)(VB + q * VP + c8) = *(const u32x4*)(Z + (size_t)(row0 + q) * EVEN_IN + EVB + g * 128 + c8); }
    __syncthreads();
    const int n = lane & 15, quad = lane >> 4, c0 = 16 * w;
    const int nkk = P >> 5, npt = P >> 4;
    bf16x8 av[4];
#pragma unroll
    for (int kk = 0; kk < 4; ++kk) { unsigned pk[4] = {0u, 0u, 0u, 0u};
        if (kk < nkk) {
#pragma unroll
            for (int x = 0; x < 4; ++x) { const unsigned lo = VB[(kk * 32 + quad * 8 + 2 * x) * VP + c0 + n], hi = VB[(kk * 32 + quad * 8 + 2 * x + 1) * VP + c0 + n]; pk[x] = lo | (hi << 16); } }
        av[kk] = __builtin_bit_cast(bf16x8, (u32x4){pk[0], pk[1], pk[2], pk[3]}); }
    const bf16* wsb = (const bf16*)(a.ws + WS_WSB) + (size_t)(j * 4 + g) * 128 * 128;
    bf16* CAT = (bf16*)(a.ws + WS_CAT);
    f32x4 acc8[8]; unsigned long long ur8[8]; float bias8[8];
#pragma unroll
    for (int pt = 0; pt < 8; ++pt) { acc8[pt] = (f32x4){0.f, 0.f, 0.f, 0.f}; ur8[pt] = 0ull; bias8[pt] = 0.f;
        if (pt < npt) { const int p = 16 * pt + n; const size_t row = (size_t)(row0 + p);
            ur8[pt] = *(const unsigned long long*)(Z + row * EVEN_IN + EU + g * 128 + c0 + quad * 4); bias8[pt] = a.in[15][(j * 4 + g) * 128 + p];
#pragma unroll
            for (int kk = 0; kk < 4; ++kk) if (kk < nkk) { const bf16x8 bw = *(const bf16x8*)(wsb + p * 128 + kk * 32 + quad * 8);
                acc8[pt] = __builtin_amdgcn_mfma_f32_16x16x32_bf16(av[kk], bw, acc8[pt], 0, 0, 0); } } }
#pragma unroll
    for (int pt = 0; pt < 8; ++pt) if (pt < npt) {
        const int p = 16 * pt + n; const size_t row = (size_t)(row0 + p); const unsigned long long ur = ur8[pt]; const float bias = bias8[pt]; const f32x4 acc = acc8[pt];
        const float u0 = __uint_as_float((unsigned)ur << 16), u1 = __uint_as_float((unsigned)ur & 0xffff0000u), u2 = __uint_as_float((unsigned)(ur >> 32) << 16), u3 = __uint_as_float((unsigned)(ur >> 32) & 0xffff0000u);
        *(unsigned long long*)(CAT + row * DM + 512 + g * 128 + c0 + quad * 4) = (unsigned long long)pk2(u0 * (acc[0] + bias), u1 * (acc[1] + bias)) | ((unsigned long long)pk2(u2 * (acc[2] + bias), u3 * (acc[3] + bias)) << 32);
    }
}
__device__ __forceinline__ void dsa_item(const Args& a, int j, int b, int zq_row0, int L, int P, int zk_row0, LAS unsigned char* lds, int w, int lane) {
    const bf16* Z = (const bf16*)(a.ws + WS_Z);
    constexpr int SSTR = 2048;
    LAS float* S = (LAS float*)lds;
    LAS int* IDX = (LAS int*)(lds + 65536);
    LAS float* PS = (LAS float*)(lds + 73728);
    LAS float* QS = (LAS float*)(lds + 106496);
    const int n = lane & 15, quad = lane >> 4, hn = n & 3;
    __syncthreads();
    {
        bf16x8 bq[2][2]; float wsc[2];
#pragma unroll
        for (int nt = 0; nt < 2; ++nt) { const bf16* zr = Z + (size_t)(zq_row0 + nt * 4 + (n >> 2)) * ODD_IN;
#pragma unroll
            for (int kk = 0; kk < 2; ++kk) bq[nt][kk] = *(const bf16x8*)(zr + OQI + hn * 64 + kk * 32 + quad * 8);
            wsc[nt] = bf2f(zr[OWI + hn]) * 0.0625f; }
        const int ntile = L >> 4;
        const float* cki = a.in[6] + (size_t)(j * 8 + b) * PAST * 64;
        for (int kt = w; kt < ntile; kt += 8) {
            const int p = kt * 16 + n; bf16x8 af[2];
            if (p < P) { const float* src = cki + (size_t)p * 64 + quad * 8;
#pragma unroll
                for (int kk = 0; kk < 2; ++kk) { const f32x4 x0 = *(const f32x4*)(src + kk * 32), x1 = *(const f32x4*)(src + kk * 32 + 4);
                    u32x4 pk; pk.x = pk2(x0.x, x0.y); pk.y = pk2(x0.z, x0.w); pk.z = pk2(x1.x, x1.y); pk.w = pk2(x1.z, x1.w); af[kk] = __builtin_bit_cast(bf16x8, pk); } }
            else { const bf16* src = Z + (size_t)(zk_row0 + p - P) * ODD_IN + OKI + quad * 8;
#pragma unroll
                for (int kk = 0; kk < 2; ++kk) af[kk] = *(const bf16x8*)(src + kk * 32); }
#pragma unroll
            for (int nt = 0; nt < 2; ++nt) { f32x4 acc = (f32x4){0.f, 0.f, 0.f, 0.f};
                acc = __builtin_amdgcn_mfma_f32_16x16x32_bf16(af[0], bq[nt][0], acc, 0, 0, 0);
                acc = __builtin_amdgcn_mfma_f32_16x16x32_bf16(af[1], bq[nt][1], acc, 0, 0, 0);
#pragma unroll
                for (int jj = 0; jj < 4; ++jj) { float v = fmaxf(acc[jj], 0.f) * wsc[nt]; v += __shfl_xor(v, 1); v += __shfl_xor(v, 2); acc[jj] = v; }
                if (hn == 0) *(LAS f32x4*)(S + (nt * 4 + (n >> 2)) * SSTR + kt * 16 + quad * 4) = acc; }
        }
    }
    __syncthreads();
    int nsel;
    {
        unsigned u[32];
#pragma unroll
        for (int i = 0; i < 32; ++i) { const int key = lane + 64 * i; unsigned x = 0u;
            if (key < L) { const unsigned bits = __float_as_uint(S[w * SSTR + key]); x = (bits & 0x80000000u) ? ~bits : (bits | 0x80000000u); }
            u[i] = x; }
        unsigned thr = 0u; int need = 0;
        if (L > 256) {
            for (int bit = 31; bit >= 0; --bit) { const unsigned cand = thr | (1u << bit); int c = 0;
#pragma unroll
                for (int i = 0; i < 32; ++i) c += (u[i] >= cand) ? 1 : 0;
                c = wave_sum_i(c); if (c >= 256) thr = cand; }
            int cg = 0;
#pragma unroll
            for (int i = 0; i < 32; ++i) cg += (u[i] > thr) ? 1 : 0;
            cg = wave_sum_i(cg); need = 256 - cg;
        }
        const unsigned long long lt = (1ull << lane) - 1ull;
        int base = 0, tie_seen = 0;
#pragma unroll
        for (int i = 0; i < 32; ++i) { if (64 * i < L) { const int key = lane + 64 * i;
            const bool gt = u[i] > thr, eq = (u[i] == thr) && (need > 0);
            const unsigned long long beq = __ballot(eq); const int rank = tie_seen + __popcll(beq & lt); tie_seen += __popcll(beq);
            const bool sel = gt || (eq && rank < need);
            const unsigned long long bs = __ballot(sel);
            if (sel) IDX[w * 256 + base + __popcll(bs & lt)] = key;
            base += __popcll(bs); } }
        nsel = base;
    }
    LDS_WAIT();
    const size_t qrow = (size_t)(zq_row0 + w);
    const float* cck = a.in[4] + (size_t)(j * 8 + b) * PAST * 128; const float* ccv = a.in[5] + (size_t)(j * 8 + b) * PAST * 128;
    bf16* CAT = (bf16*)(a.ws + WS_CAT);
#pragma unroll 1
    for (int g = 0; g < 2; ++g) {
#pragma unroll
        for (int hh = 0; hh < 4; ++hh) QS[(w * 4 + hh) * 64 + lane] = bf2f(Z[qrow * ODD_IN + OQ + (4 * g + hh) * 64 + lane]) * 0.125f;
        LDS_WAIT();
        const int njb = (nsel + 63) >> 6;
#pragma unroll 1
        for (int jb = 0; jb < njb; ++jb) { const int jpos = lane + 64 * jb; const bool valid = jpos < nsel;
            float kf[64];
            const int p = valid ? IDX[w * 256 + jpos] : 0;
            if (p < P) { const float* src = cck + ((size_t)p * 2 + g) * 64;
#pragma unroll
                for (int x = 0; x < 16; ++x) { const f32x4 t4 = *(const f32x4*)(src + 4 * x); kf[4 * x] = t4.x; kf[4 * x + 1] = t4.y; kf[4 * x + 2] = t4.z; kf[4 * x + 3] = t4.w; } }
            else { const bf16* src = Z + (size_t)(zk_row0 + p - P) * ODD_IN + OK + g * 64;
#pragma unroll
                for (int x = 0; x < 8; ++x) { float t8[8]; unpack8(*(const u32x4*)(src + 8 * x), t8);
#pragma unroll
                    for (int e = 0; e < 8; ++e) kf[8 * x + e] = t8[e]; } }
            float d[4] = {0.f, 0.f, 0.f, 0.f};
#pragma unroll
            for (int dq = 0; dq < 16; ++dq)
#pragma unroll
                for (int hh = 0; hh < 4; ++hh) { const f32x4 qv = *(const LAS f32x4*)(QS + (w * 4 + hh) * 64 + 4 * dq);
                    d[hh] += (qv.x * kf[4 * dq] + qv.y * kf[4 * dq + 1]) + (qv.z * kf[4 * dq + 2] + qv.w * kf[4 * dq + 3]); }
            if (valid) *(LAS f32x4*)(PS + (w * 256 + jpos) * 4) = (f32x4){d[0], d[1], d[2], d[3]};
        }
        LDS_WAIT();
        {
            f32x4 m4 = (f32x4){-1e30f, -1e30f, -1e30f, -1e30f};
#pragma unroll 1
            for (int jb = 0; jb < njb; ++jb) { const int jpos = lane + 64 * jb; if (jpos < nsel) { const f32x4 l4 = *(const LAS f32x4*)(PS + (w * 256 + jpos) * 4);
                m4.x = fmaxf(m4.x, l4.x); m4.y = fmaxf(m4.y, l4.y); m4.z = fmaxf(m4.z, l4.z); m4.w = fmaxf(m4.w, l4.w); } }
            m4.x = wave_max(m4.x); m4.y = wave_max(m4.y); m4.z = wave_max(m4.z); m4.w = wave_max(m4.w);
            f32x4 s4 = (f32x4){0.f, 0.f, 0.f, 0.f};
#pragma unroll 1
            for (int jb = 0; jb < njb; ++jb) { const int jpos = lane + 64 * jb; if (jpos < nsel) { f32x4 l4 = *(const LAS f32x4*)(PS + (w * 256 + jpos) * 4);
                l4.x = expf(l4.x - m4.x); l4.y = expf(l4.y - m4.y); l4.z = expf(l4.z - m4.z); l4.w = expf(l4.w - m4.w); s4 += l4;
                *(LAS f32x4*)(PS + (w * 256 + jpos) * 4) = l4; } }
            s4.x = 1.f / wave_sum(s4.x); s4.y = 1.f / wave_sum(s4.y); s4.z = 1.f / wave_sum(s4.z); s4.w = 1.f / wave_sum(s4.w);
#pragma unroll 1
            for (int jb = 0; jb < njb; ++jb) { const int jpos = lane + 64 * jb; if (jpos < nsel) { f32x4 l4 = *(const LAS f32x4*)(PS + (w * 256 + jpos) * 4);
                *(LAS f32x4*)(PS + (w * 256 + jpos) * 4) = l4 * s4; } }
        }
        LDS_WAIT();
        float o0 = 0.f, o1 = 0.f, o2 = 0.f, o3 = 0.f;
#pragma unroll 4
        for (int jp = 0; jp < nsel; ++jp) { const int p = IDX[w * 256 + jp];
            const float vv = (p < P) ? ccv[((size_t)p * 2 + g) * 64 + lane] : bf2f(Z[(size_t)(zk_row0 + p - P) * ODD_IN + OV + g * 64 + lane]);
            const f32x4 pw = *(const LAS f32x4*)(PS + (w * 256 + jp) * 4);
            o0 += pw.x * vv; o1 += pw.y * vv; o2 += pw.z * vv; o3 += pw.w * vv; }
        bf16* orow = CAT + qrow * DM + (4 * g) * 64 + lane;
        orow[0] = (bf16)f2bf(o0); orow[64] = (bf16)f2bf(o1); orow[128] = (bf16)f2bf(o2); orow[192] = (bf16)f2bf(o3);
        LDS_WAIT();
    }
}


#ifndef REP_SYNC
#define REP_SYNC 1
#endif
#ifndef REP_NORM
#define REP_NORM 1
#endif
#ifndef REP_G0
#define REP_G0 1
#endif
#ifndef REP_G2
#define REP_G2 1
#endif
#ifndef REP_DSA
#define REP_DSA 1
#endif
#ifndef REP_SB
#define REP_SB 1
#endif
#ifndef REP_GATE
#define REP_GATE 1
#endif
#ifndef REP_PRO
#define REP_PRO 1
#endif
template <int MODE> __device__ __forceinline__ void small_gemm_piece(const bf16* A, int lda, const bf16* Bt, int ldb, int row0, int col0, int k0, int klen, void* O, int ldo, int w, int lane) {
    const int n = lane & 15, quad = lane >> 4;
    const bf16* ap = A + (size_t)(row0 + 16 * (w & 3) + n) * lda + k0 + quad * 8;
    const bf16* bp0 = Bt + (size_t)(col0 + 32 * (w >> 2) + n) * ldb + k0 + quad * 8; const bf16* bp1 = bp0 + (size_t)16 * ldb;
    f32x4 acc0 = (f32x4){0.f, 0.f, 0.f, 0.f}, acc1 = (f32x4){0.f, 0.f, 0.f, 0.f};
#pragma unroll 1
    for (int k = 0; k < klen; k += 128) {
        bf16x8 af[4], b0[4], b1[4];
#pragma unroll
        for (int x = 0; x < 4; ++x) { af[x] = *(const bf16x8*)(ap + k + 32 * x); b0[x] = *(const bf16x8*)(bp0 + k + 32 * x); b1[x] = *(const bf16x8*)(bp1 + k + 32 * x); }
#pragma unroll
        for (int x = 0; x < 4; ++x) { acc0 = __builtin_amdgcn_mfma_f32_16x16x32_bf16(af[x], b0[x], acc0, 0, 0, 0); acc1 = __builtin_amdgcn_mfma_f32_16x16x32_bf16(af[x], b1[x], acc1, 0, 0, 0); }
    }
    const int r = row0 + 16 * (w & 3) + quad * 4, c = col0 + 32 * (w >> 2) + n;
#pragma unroll
    for (int jj = 0; jj < 4; ++jj) {
        if (MODE == 0) { const float x0 = fmaxf(acc0[jj], 0.f), x1 = fmaxf(acc1[jj], 0.f); bf16* o = (bf16*)O + (size_t)(r + jj) * ldo + c; o[0] = (bf16)f2bf(x0 * x0); o[16] = (bf16)f2bf(x1 * x1); }
        else { float* o = (float*)O + (size_t)(r + jj) * ldo + c; atomicAdd(o, acc0[jj]); atomicAdd(o + 16, acc1[jj]); }
    }
}
template <int W> __device__ __forceinline__ void vt_tile_store(const LAS bf16* vt, bf16* dst, int pitch, int tid) {
    if (tid < W) {
        bf16* o = dst + (size_t)tid * pitch;
#pragma unroll
        for (int c8 = 0; c8 < 8; ++c8) { unsigned pk[4];
#pragma unroll
            for (int x = 0; x < 4; ++x) { const unsigned lo = vt[(c8 * 8 + 2 * x) * W + tid], hi = vt[(c8 * 8 + 2 * x + 1) * W + tid]; pk[x] = lo | (hi << 16); }
            *(u32x4*)(o + c8 * 8) = (u32x4){pk[0], pk[1], pk[2], pk[3]}; }
    }
}
#define XB_TMO      128
#define XB_XCNT(j)  (256  + 64 * (j))
#define XB_XSUB(j)  (1280 + 64 * (j))
#define XB_XGEN(j)  (2304 + 64 * (j))
#define XB_TOP      3328
#define XB_TOPGEN   3392
#define XCD_BAR_WORDS 3456
#define XB_SPIN_CAP (1u << 18)

__device__ __forceinline__ unsigned xb_ld(unsigned* p)              { return __hip_atomic_load(p, __ATOMIC_RELAXED, __HIP_MEMORY_SCOPE_AGENT); }
__device__ __forceinline__ unsigned xb_add(unsigned* p, unsigned v) { return __hip_atomic_fetch_add(p, v, __ATOMIC_RELAXED, __HIP_MEMORY_SCOPE_AGENT); }
__device__ __forceinline__ unsigned xb_xcc_id() { return (unsigned)__builtin_amdgcn_s_getreg((3 << 11) | 20) & 0xFu; }
#define XB_SPIN(cond, bar) do { unsigned _sp = 0; while (cond) { __builtin_amdgcn_s_sleep(1); \
    if ((++_sp & 255u) == 0u) { if (xb_ld(&(bar)[XB_TMO])) break; if (_sp > XB_SPIN_CAP) { atomicAdd(&(bar)[XB_TMO], 1u); break; } } } } while (0)

struct XcdBarrier {
    unsigned* bar; unsigned x;
    volatile LAS unsigned* st;
};

__device__ __forceinline__ XcdBarrier xcd_barrier_post(unsigned* bar, volatile LAS unsigned* st) {
    XcdBarrier b; b.bar = bar; b.x = xb_xcc_id(); b.st = st;
    if (threadIdx.x == 0) (void)xb_add(&bar[XB_XCNT(b.x)], 1u);
    return b;
}
__device__ __forceinline__ void xcd_barrier_complete(unsigned* bar, unsigned x, unsigned& nloc, unsigned& nx) {
    const unsigned G = gridDim.x * gridDim.y * gridDim.z;
    unsigned sum, cnt, mine, sp = 0u;
    for (;;) {
        sum = 0u; cnt = 0u; mine = 0u;
#pragma unroll
        for (unsigned j = 0; j < 16; ++j) { const unsigned c = xb_ld(&bar[XB_XCNT(j)]); sum += c; cnt += (c > 0u) ? 1u : 0u; mine = (j == x) ? c : mine; }
        if (sum == G) break;
        __builtin_amdgcn_s_sleep(1);
        if ((++sp & 255u) == 0u) { if (xb_ld(&bar[XB_TMO])) break; if (sp > XB_SPIN_CAP) { atomicAdd(&bar[XB_TMO], 1u); break; } }
    }
    nloc = mine > 0u ? mine : 1u; nx = cnt > 0u ? cnt : 1u;
}

__device__ __forceinline__ void xcd_barrier(const XcdBarrier& b) {
    asm volatile("s_waitcnt vmcnt(0)" ::: "memory");
    __syncthreads();
    if (threadIdx.x == 0) {
        unsigned* bar = b.bar;
        __builtin_amdgcn_s_waitcnt(0);
        unsigned nloc = b.st[0], nx = b.st[1];
        if (nloc == 0u) { xcd_barrier_complete(bar, b.x, nloc, nx); b.st[0] = nloc; b.st[1] = nx; }
        const unsigned old = xb_add(&bar[XB_XSUB(b.x)], 1u);
        const unsigned gen = old / nloc;
        if (old + 1u == (gen + 1u) * nloc) {
            __builtin_amdgcn_fence(__ATOMIC_RELEASE, "agent");
            asm volatile("s_waitcnt vmcnt(0)" ::: "memory");
            const unsigned og = xb_add(&bar[XB_TOP], 1u);
            const unsigned tg = og / nx;
            if (og + 1u == (tg + 1u) * nx) xb_add(&bar[XB_TOPGEN], 1u);
            else XB_SPIN(xb_ld(&bar[XB_TOPGEN]) == tg, bar);
            __builtin_amdgcn_fence(__ATOMIC_ACQUIRE, "agent");
            xb_add(&bar[XB_XGEN(b.x)], 1u);
            asm volatile("s_waitcnt vmcnt(0)" ::: "memory");
        } else {
            XB_SPIN(xb_ld(&bar[XB_XGEN(b.x)]) == gen, bar);
            __builtin_amdgcn_fence(__ATOMIC_ACQUIRE, "agent");
            asm volatile("s_waitcnt vmcnt(0)" ::: "memory");
        }
    }
    __syncthreads();
}

#ifndef PROBE_DUP_SUB
#define PROBE_DUP_SUB -1
#endif
constexpr int N_PHASES = 1 + 4 * (PROBE_DUP_SUB >= 0 ? 9 : 8);
__global__ void __launch_bounds__(512, 2) mega_fwd(Args a) {
    extern __shared__ __attribute__((aligned(16))) unsigned char lds_raw[];
    LAS unsigned char* lds = (LAS unsigned char*)lds_raw;
    cg::grid_group grid = cg::this_grid();
    const int G = gridDim.x;
    typedef const __attribute__((address_space(4))) unsigned char* kptr_t; typedef const float* cfp_t; typedef float* fp_t; typedef unsigned char* ucp_t;
    const kptr_t kp0 = (kptr_t)__builtin_amdgcn_kernarg_segment_ptr();
    unsigned char* ws0 = a.ws;
    if (threadIdx.x < 4) ((LAS unsigned*)(lds + LDS_BARST))[threadIdx.x] = 0u;
    __syncthreads();
    (void)xcd_barrier_post((unsigned*)(ws0 + WS_CTL), (volatile LAS unsigned*)(lds + LDS_BARST));
#pragma unroll 1
    for (int pi = a.ph_lo; pi < a.ph_hi; ++pi) {
#if PROBE_DUP_SUB >= 0
        int ph = pi; if (pi > 0) { const int l9 = (pi - 1) / 9, s9 = (pi - 1) % 9; ph = 1 + l9 * 8 + (s9 <= PROBE_DUP_SUB ? s9 : s9 - 1); }
#else
        const int ph = pi;
#endif
        kptr_t kp = kp0; asm volatile("" : "+s"(kp));
        Args al;
#pragma unroll
        for (int i = 0; i < 24; ++i) al.in[i] = *(const cfp_t __attribute__((address_space(4)))*)(kp + 8 * i);
        al.out = *(const fp_t __attribute__((address_space(4)))*)(kp + 192); al.ws = *(const ucp_t __attribute__((address_space(4)))*)(kp + 200);
        al.ph_lo = a.ph_lo; al.ph_hi = a.ph_hi;
        unsigned char* ws = al.ws;
        bf16* H = (bf16*)(ws + WS_H); bf16* Zb = (bf16*)(ws + WS_Z); bf16* CAT = (bf16*)(ws + WS_CAT); bf16* ACT = (bf16*)(ws + WS_ACT);
        int tid_l = threadIdx.x; asm volatile("" : "+v"(tid_l));
        const int tid = tid_l, lane = tid & 63, w = __builtin_amdgcn_readfirstlane(tid >> 6);
        const int gw = blockIdx.x * 8 + w, NGW = G * 8;
        if (ph == 0) { for (int rep_ = 0; rep_ < REP_PRO; ++rep_) { p_prologue(al, lds, gw, NGW, w, lane); } }
        else {
            const int li = (ph - 1) >> 3, sub = (ph - 1) & 7, j = li >> 1; const bool odd = li & 1;
            if (sub == 0) { for (int rep_ = 0; rep_ < REP_NORM; ++rep_) { if (li > 0) p_norm(al, al.in[8] + li * DM, gw, NGW, lane); } }
            else if (sub == 1) {
                const int N = odd ? ODD_IN : EVEN_IN;
                const bf16* Wt = odd ? (const bf16*)(ws + WS_WINO) + (size_t)j * ODD_IN * DM : (const bf16*)(ws + WS_WINE) + (size_t)j * EVEN_IN * DM;
                pg8::Gemm g{H, Wt, MT, N, DM}; pg8::StaticOrder S; S.init(MT, N, G, (int)blockIdx.x);
                pg8::EpiBf16<0> E{Zb, N};
                for (int rep_ = 0; rep_ < REP_G0; ++rep_) { pg8::gemm_phase<pg8::EpiBf16<0>, pg8::StaticOrder, true, true>(lds, g, S, E, w); }
                {
                    const int nwg = (MT / 256) * (N / 256), nfull = nwg / G, first_idle = nwg - nfull * G;
                    const int nidle = G - first_idle; LAS bf16* vts = (LAS bf16*)lds;
                    if ((int)blockIdx.x >= first_idle && nidle > 0) {
                        for (int tile = (int)blockIdx.x - first_idle; tile < 128; tile += nidle) { __syncthreads();
                            int lane_c = lane; asm volatile("" : "+v"(lane_c));
                            if (odd) {
#pragma unroll 1
                                for (int i = 0; i < 8; ++i) cache_c_row(al, j, tile * 64 + w * 8 + i, lane_c, vts + (w * 8 + i) * 128);
                                __syncthreads();
                                vt_tile_store<128>(vts, (bf16*)(ws + WS_VTS) + (size_t)(tile >> 4) * 2 * 64 * SKL + (tile & 15) * 64, SKL, tid);
                            } else {
#pragma unroll 1
                                for (int i = 0; i < 8; ++i) cache_a_row(al, j, tile * 64 + w * 8 + i, lane_c, vts + (w * 8 + i) * 512);
                                __syncthreads();
                                vt_tile_store<512>(vts, (bf16*)(ws + WS_VTSA) + (size_t)(tile >> 4) * 8 * 64 * SKL + (tile & 15) * 64, SKL, tid);
                            } }
                    }
                }
            }
            else if (sub == 2) {
                LAS bf16* vts = (LAS bf16*)lds;
                if (odd) {
                    int lane_o = lane; asm volatile("" : "+v"(lane_o));
                    for (int tile = blockIdx.x; tile < 256; tile += G) { __syncthreads();
                        OdRaw cur; odd_load(al, j, tile * 64 + w * 8, lane_o, cur);
#pragma unroll 1
                        for (int i = 0; i < 8; ++i) { OdRaw nx; odd_load(al, j, tile * 64 + w * 8 + (i < 7 ? i + 1 : i), lane_o, nx);
                            odd_post_row(al, j, tile * 64 + w * 8 + i, lane_o, vts + (w * 8 + i) * 128, true, cur); cur = nx; }
                        __syncthreads();
                        vt_tile_store<128>(vts, (bf16*)(ws + WS_VTP) + (size_t)(tile >> 5) * 2 * 64 * VTL + (tile & 31) * 64, VTL, tid); }
                    for (int r = MP + gw; r < MT; r += NGW) { OdRaw one; odd_load(al, j, r, lane_o, one); odd_post_row(al, j, r, lane_o, vts, false, one); }
                } else {
                    int lane_e = lane; asm volatile("" : "+v"(lane_e));
                    for (int tile = blockIdx.x; tile < 256; tile += G) { __syncthreads();
                        EvRaw cur = even_load(Zb + (size_t)(tile * 64 + w * 8) * EVEN_IN, lane_e);
#pragma unroll 1
                        for (int i = 0; i < 8; ++i) { const EvRaw nx = even_load(Zb + (size_t)(tile * 64 + w * 8 + (i < 7 ? i + 1 : i)) * EVEN_IN, lane_e);
                            even_post_row(al, j, tile * 64 + w * 8 + i, lane_e, vts + (w * 8 + i) * 512, true, cur); cur = nx; }
                        __syncthreads();
                        vt_tile_store<512>(vts, (bf16*)(ws + WS_VTA) + (size_t)(tile >> 5) * 8 * 64 * VTL + (tile & 31) * 64, VTL, tid); }
                    for (int r = MP + gw; r < MT; r += NGW) { const EvRaw one = even_load(Zb + (size_t)r * EVEN_IN, lane_e); even_post_row(al, j, r, lane_e, vts, false, one); }
                }
            }
            else if (sub == 3) {
                if (odd) {
                  for (int rep_ = 0; rep_ < REP_DSA; ++rep_) {
                    unsigned* ticket = (unsigned*)(ws + WS_CTL) + 3584 + 64 * (j + 2 * rep_);
                    volatile LAS int* nxt = (volatile LAS int*)(lds + LDS_BARST + 8);
                    for (;;) {
                        __syncthreads();
                        if (tid == 0) *nxt = (int)__hip_atomic_fetch_add(ticket, 1u, __ATOMIC_RELAXED, __HIP_MEMORY_SCOPE_AGENT);
                        __syncthreads();
                        const int t = *nxt;
                        if (t >= 520) break;
                        if (t >= 256 && t < 264) { const int b = t - 256;
                            DsaSrc src{(const bf16*)(ws + WS_KS) + (size_t)b * SKL * 128, 128, (const bf16*)(ws + WS_KIS) + (size_t)b * SKL * 64, 64, (const bf16*)(ws + WS_VTS) + (size_t)b * 2 * 64 * SKL, SKL};
                            dsa2_item(al, src, MP + b * ST, PAST + ST, lds, w, lane); }
                        else { const int kk = t < 256 ? t : t - 8; const int c = 31 - (kk >> 4), rem = kk & 15, b = rem >> 1, hf = rem & 1;
                            const bf16* zb = Zb + (size_t)b * SEQ * ODD_IN;
                            DsaSrc src{zb + OK, ODD_IN, zb + OKI, ODD_IN, (const bf16*)(ws + WS_VTP) + (size_t)b * 2 * 64 * VTL, VTL};
                            dsa2_item(al, src, b * SEQ + c * 64 + hf * 32, 64 * (c + 1), lds, w, lane); }
                    }
                  }
                } else {
                    for (int rep_ = 0; rep_ < REP_SB; ++rep_) {
                        unsigned* ticket = (unsigned*)(ws + WS_CTL) + 3840 + 64 * (j + 2 * rep_);
                        volatile LAS int* nxt = (volatile LAS int*)(lds + LDS_BARST + 8);
                        for (;;) {
                            __syncthreads();
                            if (tid == 0) *nxt = (int)__hip_atomic_fetch_add(ticket, 1u, __ATOMIC_RELAXED, __HIP_MEMORY_SCOPE_AGENT);
                            __syncthreads();
                            const int t = *nxt;
                            if (t >= 1040) break;
                            if (t < 16) { const int s = t * 8 + w, bh = s >> 1, hf = s & 1, b = bh >> 3, h = bh & 7;
                                SbSrc src{(const bf16*)(ws + WS_KSA) + (size_t)b * SKL * 512 + h * 64, 512, (const bf16*)(ws + WS_VTSA) + (size_t)bh * 64 * SKL, SKL};
                                sb2_wave_item(al, src, MP + b * ST + hf * 16, h * 64, PAST + hf * 16, lane); }
                            else { const int id = (t - 16) * 8 + w, bh = id >> 7, qt = 127 - (id & 127), b = bh >> 3, h = bh & 7;
                                SbSrc src{Zb + (size_t)b * SEQ * EVEN_IN + EK + h * 64, EVEN_IN, (const bf16*)(ws + WS_VTA) + (size_t)bh * 64 * VTL, VTL};
                                sb2_wave_item(al, src, b * SEQ + qt * 16, h * 64, qt * 16, lane); }
                        }
                    }
                    for (int rep_ = 0; rep_ < REP_GATE; ++rep_) { for (int it = blockIdx.x; it < 512 + 32; it += G) gate2_item(al, j, it, lds, tid, w, lane); }
                }
            }
            else if (sub == 4) {
                const bf16* Wo = (const bf16*)(ws + WS_WOUT) + (size_t)li * DM * DM;
                pg8::Gemm g{CAT, Wo, MP, DM, DM}; pg8::StaticOrder S; S.init(MP, DM, G, (int)blockIdx.x);
                pg8::EpiRes E{al.out, DM};
                pg8::gemm_phase<pg8::EpiRes, pg8::StaticOrder, true, true>(lds, g, S, E, w);
                for (int pc = blockIdx.x; pc < 256; pc += G) { const int st = pc >> 2, ks = pc & 3;
                    small_gemm_piece<1>(CAT, DM, Wo, DM, MP + (st >> 4) * 64, (st & 15) * 64, ks * 256, 256, al.out, DM, w, lane); }
            }
            else if (sub == 5) { for (int rep_ = 0; rep_ < REP_NORM; ++rep_) { p_norm(al, al.in[9] + li * DM, gw, NGW, lane); } }
            else if (sub == 6) {
                const bf16* W1 = (const bf16*)(ws + WS_W1) + (size_t)li * FF * DM;
                pg8::Gemm g{H, W1, MP, FF, DM}; pg8::StaticOrder S; S.init(MP, FF, G, (int)blockIdx.x);
                pg8::EpiBf16<2> E{ACT, FF};
                for (int rep_ = 0; rep_ < REP_G2; ++rep_) { pg8::gemm_phase<pg8::EpiBf16<2>, pg8::StaticOrder, true, true>(lds, g, S, E, w); }
                for (int pc = blockIdx.x; pc < 256; pc += G) small_gemm_piece<0>(H, DM, W1, DM, MP + (pc >> 6) * 64, (pc & 63) * 64, 0, DM, ACT, FF, w, lane);
            }
            else {
                const bf16* W2 = (const bf16*)(ws + WS_W2) + (size_t)li * DM * FF;
                pg8::Gemm g{ACT, W2, MP, DM, FF}; pg8::StaticOrder S; S.init(MP, DM, G, (int)blockIdx.x);
                pg8::EpiRes E{al.out, DM};
                pg8::gemm_phase<pg8::EpiRes, pg8::StaticOrder, true, true>(lds, g, S, E, w);
                for (int pc = blockIdx.x; pc < 256; pc += G) { const int st = pc >> 2, ks = pc & 3;
                    small_gemm_piece<1>(ACT, FF, W2, FF, MP + (st >> 4) * 64, (st & 15) * 64, ks * 1024, 1024, al.out, DM, w, lane); }
            }
        }
        if (pi + 1 < al.ph_hi) { for (int rep_ = 0; rep_ < REP_SYNC; ++rep_) { if (al.ph_lo < 0) grid.sync();   { XcdBarrier xb; xb.bar = (unsigned*)(ws + WS_CTL); xb.x = xb_xcc_id(); xb.st = (volatile LAS unsigned*)(lds + LDS_BARST); xcd_barrier(xb); } } }
    }
}

#ifndef MK_MULTI
#define MK_MULTI 0
#endif
extern "C" void kernel_launch(void* const* d_in, const int* in_sizes, int n_in, void* d_out, int out_size, void* d_ws, size_t ws_size, hipStream_t stream) {
    static int grid = 0;
    if (grid == 0) {
        int dev = 0, cus = 0, per_cu = 0;
        hipGetDevice(&dev); hipDeviceGetAttribute(&cus, hipDeviceAttributeMultiprocessorCount, dev);
        if (hipFuncSetAttribute((const void*)mega_fwd, hipFuncAttributeMaxDynamicSharedMemorySize, LDS_BYTES) != hipSuccess) fprintf(stderr, "kernel_launch: hipFuncSetAttribute failed\n");
        if (hipOccupancyMaxActiveBlocksPerMultiprocessor(&per_cu, (const void*)mega_fwd, 512, LDS_BYTES) != hipSuccess || per_cu < 1) { fprintf(stderr, "kernel_launch: occupancy query says %d\n", per_cu); per_cu = 1; }
        (void)hipGetLastError();
        if (cus <= 0) cus = 256;
        grid = cus;
        if (n_in != 24 || (size_t)out_size != OUT_TOTAL || ws_size < WS_END2) fprintf(stderr, "kernel_launch: unexpected sizes n_in %d out %d ws %zu\n", n_in, out_size, ws_size);
    }
    Args a{};
    for (int i = 0; i < 24; ++i) a.in[i] = (const float*)d_in[i];
    a.out = (float*)d_out; a.ws = (unsigned char*)d_ws;
#if MK_MULTI
    for (int ph = 0; ph < N_PHASES; ++ph) { if (ph == 1) continue; a.ph_lo = ph; a.ph_hi = ph + 1; hipLaunchKernelGGL(mega_fwd, dim3(grid), dim3(512), LDS_BYTES, stream, a); }
#else
    if (hipMemsetAsync((unsigned char*)d_ws + WS_CTL, 0, CTL_BYTES, stream) != hipSuccess) fprintf(stderr, "kernel_launch: memset failed\n");
    a.ph_lo = 0; a.ph_hi = N_PHASES;
    void* args[] = {&a};
    hipError_t e = hipLaunchCooperativeKernel((const void*)mega_fwd, dim3(grid), dim3(512), args, LDS_BYTES, stream);
    if (e != hipSuccess) fprintf(stderr, "kernel_launch: cooperative launch failed: %s (grid %d)\n", hipGetErrorString(e), grid);
#endif
}
```

```cpp
#include <hip/hip_runtime.h>
#include <hip/hip_cooperative_groups.h>
#include <cstdio>
#include <cstdint>
#include <cstddef>
namespace cg = cooperative_groups;
namespace pg8 {
#define PG8_LAS __attribute__((address_space(3)))
typedef unsigned short bf16_t;
typedef short bf16x8 __attribute__((ext_vector_type(8)));
typedef float f32x4 __attribute__((ext_vector_type(4)));
typedef unsigned u32x4 __attribute__((ext_vector_type(4)));
constexpr int BM = 256, BK = 64, HALF = 128, HTB = HALF * BK * 2  , STAGE_BYTES = 8 * HTB, NXCD = 8, WGM = 8;

__host__ __device__ __forceinline__ int lds_byte(int r, int c) { const int st = (r >> 4) * 2 + (c >> 5), rr = r & 15, cc = c & 31, ob = rr * 64 + cc * 2; return st * 1024 + (ob ^ (((ob >> 9) & 1) << 5)); }
__host__ __device__ __forceinline__ void stage_rc(int b, int& R, int& C) { const int st = b / 1024, sb = b % 1024, swz = sb ^ (((sb >> 9) & 1) << 5); R = (st >> 1) * 16 + swz / 64; C = (st & 1) * 32 + (swz % 64) / 2; }
__host__ __device__ __forceinline__ int perm32(int rho) { const int n = rho >> 4, i = rho & 15; return 8 * (i >> 2) + 4 * n + (i & 3); }

struct Unit { int pm, pn; };
struct Gemm { const bf16_t* A; const bf16_t* Bt; int M, N, K; };

struct StaticOrder {
    int nM, nN, nwg, G, c;
    __host__ __device__ void init(int M, int N, int G_, int c_) { nM = M / BM; nN = N / BM; nwg = nM * nN; G = G_; c = c_; }
    __host__ __device__ bool next(int i, Unit& u) const {
        const long L = (long)i * G + c; if (L >= nwg) return false;
        int wgid = (int)L; { const int q = nwg / NXCD, r = nwg % NXCD, xcd = wgid % NXCD, off = wgid / NXCD; wgid = (xcd < r ? xcd * (q + 1) : r * (q + 1) + (xcd - r) * q) + off; }
        const int nig = WGM * nN, gid = wgid / nig, fm = gid * WGM, gsz = (nM - fm) < WGM ? (nM - fm) : WGM;
        u.pm = fm + ((wgid % nig) % gsz); u.pn = (wgid % nig) / gsz; return true;
    }
    __device__ __forceinline__ void a_ready(const Unit&) const {}
    __device__ __forceinline__ void done(const Unit&) const {}
};

__device__ __forceinline__ unsigned cvt_pk_bf16(float lo, float hi) { unsigned r; asm volatile("v_cvt_pk_bf16_f32 %0, %1, %2" : "=v"(r) : "v"(lo), "v"(hi)); return r; }
template <int ACT  > struct EpiBf16 {
    static constexpr bool PERM = true, AFTER_DRAIN = false;
    bf16_t* O; int ldc;
    __device__ __forceinline__ void operator()(const f32x4 (&acc)[2][2][4][2], const Unit& u, int wr, int wc, int fr, int fq) const {
        const int row0 = u.pm * BM + wr * 64 + fr, col0 = u.pn * BM + wc * 32 + 8 * fq;
#pragma unroll
        for (int ai = 0; ai < 2; ++ai)
#pragma unroll
            for (int m = 0; m < 4; ++m) { bf16_t* rowp = O + (size_t)(row0 + ai * HALF + m * 16) * ldc + col0;
#pragma unroll
                for (int bj = 0; bj < 2; ++bj) { f32x4 v0 = acc[ai][bj][m][0], v1 = acc[ai][bj][m][1];
                    if (ACT == 2) {
#pragma unroll
                        for (int e = 0; e < 4; ++e) { const float a0 = fmaxf(v0[e], 0.f), a1 = fmaxf(v1[e], 0.f); v0[e] = a0 * a0; v1[e] = a1 * a1; } }
                    u32x4 w; w.x = cvt_pk_bf16(v0[0], v0[1]); w.y = cvt_pk_bf16(v0[2], v0[3]); w.z = cvt_pk_bf16(v1[0], v1[1]); w.w = cvt_pk_bf16(v1[2], v1[3]);
                    *(u32x4*)(rowp + bj * HALF) = w; } }
    }
};
struct EpiRes {
    static constexpr bool PERM = false, AFTER_DRAIN = false;
    float* X; int ldc;
    __device__ __forceinline__ void operator()(const f32x4 (&acc)[2][2][4][2], const Unit& u, int wr, int wc, int fr, int fq) const {
        const int row0 = u.pm * BM + wr * 64 + fr, col0 = u.pn * BM + wc * 32 + 4 * fq;
        f32x4 cur[4], nxt[4];
        { const float* rowp = X + (size_t)row0 * ldc + col0;
#pragma unroll
          for (int q = 0; q < 4; ++q) cur[q] = *(const f32x4*)(rowp + (q >> 1) * HALF + (q & 1) * 16); }
#pragma unroll
        for (int gidx = 0; gidx < 8; ++gidx) { const int ai = gidx >> 2, m = gidx & 3;
            float* rowp = X + (size_t)(row0 + ai * HALF + m * 16) * ldc + col0;
            if (gidx < 7) { const int ai2 = (gidx + 1) >> 2, m2 = (gidx + 1) & 3; const float* rp2 = X + (size_t)(row0 + ai2 * HALF + m2 * 16) * ldc + col0;
#pragma unroll
                for (int q = 0; q < 4; ++q) nxt[q] = *(const f32x4*)(rp2 + (q >> 1) * HALF + (q & 1) * 16); }
#pragma unroll
            for (int q = 0; q < 4; ++q) *(f32x4*)(rowp + (q >> 1) * HALF + (q & 1) * 16) = cur[q] + acc[ai][q >> 1][m][q & 1];
            asm volatile("" ::: "memory");
#pragma unroll
            for (int q = 0; q < 4; ++q) cur[q] = nxt[q]; }
    }
};
template <class Epi, class Sched, bool ALIGN_EPI = false, bool SP2 = false>
__device__ __forceinline__ void gemm_phase(PG8_LAS unsigned char* lds, const Gemm g, const Sched& S, const Epi& E, int wid_in) {
    int tid_l = threadIdx.x; asm volatile("" : "+v"(tid_l));
    const int tid = tid_l, wid = __builtin_amdgcn_readfirstlane(tid >> 6), lane = tid & 63, wr = wid >> 2, wc = wid & 3, fr = lane & 15, fq = lane >> 4;
    const int K = g.K, nt = K / BK;
    unsigned voffA[2], voffB[2];
#pragma unroll
    for (int i = 0; i < 2; ++i) { int R, C; stage_rc(tid * 16 + i * 8192, R, C); const int Rb = Epi::PERM ? ((R & ~31) + perm32(R & 31)) : R;
        voffA[i] = (unsigned)(R * K + C) * 2u; voffB[i] = (unsigned)(Rb * K + C) * 2u; }
    const size_t kstep = (size_t)(BK * 2);
    const size_t hstep = (size_t)HALF * K * 2;
    const size_t tstep = 2 * hstep;
    const unsigned ldsw = (unsigned)wid * 1024u;
    const int aoff = lds_byte(wr * 64 + fr, fq * 8), boff = lds_byte(wc * 32 + fr, fq * 8);
#define PG8_SA(b, h) (((b) * 2 + (h)) * HTB)
#define PG8_SB(b, h) ((4 + (b) * 2 + (h)) * HTB)
#define PG8_STAGE(bufoff, gbase, voff) do { _Pragma("unroll") for (int _i = 0; _i < 2; ++_i) \
        __builtin_amdgcn_global_load_lds((const unsigned*)((const char*)(gbase) + (voff)[_i]), (PG8_LAS unsigned*)(lds + (bufoff) + ldsw + _i * 8192), 16, 0, 0); } while (0)
#define PG8_LDA(dst, b, h) do { _Pragma("unroll") for (int m = 0; m < 4; ++m) _Pragma("unroll") for (int k = 0; k < 2; ++k) dst[m][k] = *(const PG8_LAS bf16x8*)(lds + PG8_SA(b, h) + aoff + m * 2048 + k * 1024); } while (0)
#define PG8_LDB(dst, b, h) do { _Pragma("unroll") for (int n = 0; n < 2; ++n) _Pragma("unroll") for (int k = 0; k < 2; ++k) dst[n][k] = *(const PG8_LAS bf16x8*)(lds + PG8_SB(b, h) + boff + n * 2048 + k * 1024); } while (0)
#define PG8_MMA(ai, bj, At, Bt) do { __builtin_amdgcn_s_setprio(1); _Pragma("unroll") for (int m = 0; m < 4; ++m) _Pragma("unroll") for (int n = 0; n < 2; ++n) _Pragma("unroll") for (int k = 0; k < 2; ++k) \
        acc[ai][bj][m][n] = __builtin_amdgcn_mfma_f32_16x16x32_bf16(Bt[n][k], At[m][k], acc[ai][bj][m][n], 0, 0, 0); __builtin_amdgcn_s_setprio(0); } while (0)
#define PG8_WAIT_V(n) asm volatile("s_waitcnt vmcnt(" #n ")" ::: "memory")
#define PG8_WAIT_L(n) asm volatile("s_waitcnt lgkmcnt(" #n ")" ::: "memory")
#define PG8_BAR __builtin_amdgcn_s_barrier()
#define PG8_SCHED __builtin_amdgcn_sched_barrier(0)
    Unit cur, nxt; int ui = 0;
    if (!S.next(0, cur)) return;
    f32x4 acc[2][2][4][2];
#pragma unroll
    for (int a = 0; a < 2; ++a)
#pragma unroll
        for (int b = 0; b < 2; ++b)
#pragma unroll
            for (int m = 0; m < 4; ++m)
#pragma unroll
                for (int n = 0; n < 2; ++n) acc[a][b][m][n] = (f32x4){0.f, 0.f, 0.f, 0.f};
    bf16x8 At[4][2], B0[2][2], B1[2][2];
    const char* cA = (const char*)g.A + (size_t)cur.pm * tstep; const char* cB = (const char*)g.Bt + (size_t)cur.pn * tstep;
    S.a_ready(cur);
    if constexpr (SP2) {
        PG8_STAGE(PG8_SB(0, 0), cB, voffB); PG8_STAGE(PG8_SB(0, 1), cB + hstep, voffB); PG8_STAGE(PG8_SA(0, 0), cA, voffA); PG8_STAGE(PG8_SA(0, 1), cA + hstep, voffA);
        if (wr == 1) PG8_BAR;
        PG8_WAIT_V(2); PG8_BAR;
        PG8_STAGE(PG8_SB(1, 0), cB + kstep, voffB); PG8_STAGE(PG8_SA(1, 0), cA + kstep, voffA); PG8_STAGE(PG8_SB(1, 1), cB + hstep + kstep, voffB);
        PG8_WAIT_V(6); PG8_BAR;
    } else {
        PG8_STAGE(PG8_SB(0, 0), cB, voffB); PG8_STAGE(PG8_SA(0, 0), cA, voffA); PG8_STAGE(PG8_SB(0, 1), cB + hstep, voffB); PG8_STAGE(PG8_SA(0, 1), cA + hstep, voffA);
        if (wr == 1) PG8_BAR;
        PG8_WAIT_V(4); PG8_BAR;
        PG8_STAGE(PG8_SB(1, 0), cB + kstep, voffB); PG8_STAGE(PG8_SA(1, 0), cA + kstep, voffA); PG8_STAGE(PG8_SB(1, 1), cB + hstep + kstep, voffB);
        PG8_WAIT_V(6); PG8_BAR;
    }
    for (;;) {
        const bool has_next = S.next(ui + 1, nxt);
        const char* nA = has_next ? (const char*)g.A + (size_t)nxt.pm * tstep : cA; const char* nB = has_next ? (const char*)g.Bt + (size_t)nxt.pn * tstep : cB;
        for (int t = 0; t < nt; t += 2) {
            const bool last = (t == nt - 2);
            const char* a1 = cA + (size_t)(t + 1) * kstep;
            const char* a2 = last ? nA : cA + (size_t)(t + 2) * kstep; const char* b2 = last ? nB : cB + (size_t)(t + 2) * kstep;
            const char* a3 = a2 + kstep; const char* b3 = b2 + kstep;
            if (last && has_next) S.a_ready(nxt);
            if constexpr (SP2) {
            PG8_LDB(B0, 0, 0); PG8_LDB(B1, 0, 1); PG8_SCHED; PG8_LDA(At, 0, 0); PG8_STAGE(PG8_SA(1, 1), a1 + hstep, voffA);
            PG8_WAIT_V(8); PG8_WAIT_L(0); PG8_BAR; PG8_MMA(0, 0, At, B0); PG8_MMA(0, 1, At, B1); PG8_BAR; PG8_SCHED;
            PG8_LDA(At, 0, 1); PG8_STAGE(PG8_SB(0, 0), b2, voffB); PG8_STAGE(PG8_SB(0, 1), b2 + hstep, voffB); PG8_STAGE(PG8_SA(0, 0), a2, voffA);
            PG8_WAIT_V(8); PG8_WAIT_L(0); PG8_BAR; PG8_MMA(1, 0, At, B0); PG8_MMA(1, 1, At, B1); PG8_BAR; PG8_SCHED;
            PG8_LDB(B0, 1, 0); PG8_LDB(B1, 1, 1); PG8_SCHED; PG8_LDA(At, 1, 0); PG8_STAGE(PG8_SA(0, 1), a2 + hstep, voffA);
            PG8_WAIT_V(8); PG8_WAIT_L(0); PG8_BAR; PG8_MMA(0, 0, At, B0); PG8_MMA(0, 1, At, B1); PG8_BAR; PG8_SCHED;
            PG8_LDA(At, 1, 1); PG8_STAGE(PG8_SB(1, 0), b3, voffB); PG8_STAGE(PG8_SB(1, 1), b3 + hstep, voffB); PG8_STAGE(PG8_SA(1, 0), a3, voffA);
            PG8_WAIT_V(8); PG8_WAIT_L(0); PG8_BAR; PG8_MMA(1, 0, At, B0); PG8_MMA(1, 1, At, B1); PG8_BAR; PG8_SCHED;
            } else {
            PG8_LDB(B0, 0, 0); PG8_SCHED; PG8_LDA(At, 0, 0); PG8_STAGE(PG8_SA(1, 1), a1 + hstep, voffA);
            PG8_WAIT_L(8); PG8_BAR; PG8_WAIT_L(0); PG8_MMA(0, 0, At, B0); PG8_BAR; PG8_SCHED;
            PG8_LDB(B1, 0, 1); PG8_STAGE(PG8_SB(0, 0), b2, voffB);
            PG8_BAR; PG8_WAIT_L(0); PG8_MMA(0, 1, At, B1); PG8_BAR;
            PG8_LDA(At, 0, 1); PG8_STAGE(PG8_SA(0, 0), a2, voffA);
            PG8_BAR; PG8_WAIT_L(0); PG8_MMA(1, 0, At, B0); PG8_BAR; PG8_SCHED;
            PG8_STAGE(PG8_SB(0, 1), b2 + hstep, voffB);
            PG8_WAIT_V(6); PG8_BAR; PG8_MMA(1, 1, At, B1); PG8_BAR;
            PG8_LDB(B0, 1, 0); PG8_SCHED; PG8_LDA(At, 1, 0); PG8_STAGE(PG8_SA(0, 1), a2 + hstep, voffA);
            PG8_WAIT_L(8); PG8_BAR; PG8_WAIT_L(0); PG8_MMA(0, 0, At, B0); PG8_BAR; PG8_SCHED;
            PG8_LDB(B1, 1, 1); PG8_STAGE(PG8_SB(1, 0), b3, voffB);
            PG8_BAR; PG8_WAIT_L(0); PG8_MMA(0, 1, At, B1); PG8_BAR;
            PG8_LDA(At, 1, 1); PG8_STAGE(PG8_SA(1, 0), a3, voffA);
            PG8_BAR; PG8_WAIT_L(0); PG8_MMA(1, 0, At, B0); PG8_BAR; PG8_SCHED;
            PG8_STAGE(PG8_SB(1, 1), b3 + hstep, voffB);
            PG8_WAIT_V(6); PG8_BAR; PG8_MMA(1, 1, At, B1); PG8_BAR;
            }
        }
        if constexpr (ALIGN_EPI) { if (wr == 0) PG8_BAR; }
        if constexpr (!Epi::AFTER_DRAIN) { E(acc, cur, wr, wc, fr, fq); S.done(cur); }
        if (!has_next) break;
#pragma unroll
        for (int a = 0; a < 2; ++a)
#pragma unroll
            for (int b = 0; b < 2; ++b)
#pragma unroll
                for (int m = 0; m < 4; ++m)
#pragma unroll
                    for (int n = 0; n < 2; ++n) acc[a][b][m][n] = (f32x4){0.f, 0.f, 0.f, 0.f};
        cur = nxt; cA = nA; cB = nB; ++ui;
        if constexpr (ALIGN_EPI) { if (wr == 1) PG8_BAR; }
    }
    PG8_WAIT_V(0);
    if constexpr (!ALIGN_EPI) { if (wr == 0) PG8_BAR; }
    PG8_BAR;
    if constexpr (Epi::AFTER_DRAIN) { E.fused(acc, cur, wr, wc, fr, fq, lds, wid, lane); S.done(cur); }
#undef PG8_SA
#undef PG8_SB
#undef PG8_STAGE
#undef PG8_LDA
#undef PG8_LDB
#undef PG8_MMA
#undef PG8_WAIT_V
#undef PG8_WAIT_L
#undef PG8_BAR
#undef PG8_SCHED
}
}
#ifndef REP_D1
#define REP_D1 1
#endif
#ifndef REP_D2
#define REP_D2 1
#endif
#ifndef REP_D3
#define REP_D3 1
#endif

#define LAS __attribute__((address_space(3)))
typedef unsigned short bf16;
typedef float f32x4 __attribute__((ext_vector_type(4)));
typedef unsigned u32x4 __attribute__((ext_vector_type(4)));
typedef short bf16x8 __attribute__((ext_vector_type(8)));

constexpr int DM = 1024, NBATCH = 8, SEQ = 2048, SB = 8, ST = 32, PAST = 1024, FF = 4096;
constexpr int MP = NBATCH * SEQ, MS = SB * ST, MT = MP + MS;
constexpr int EVEN_IN = 2560, ODD_SRC = 2628, ODD_IN = 2816;
constexpr int EQ = 0, EK = 512, EV = 1024, EU = 1536, EVB = 2048;
constexpr int OQ = 0, OK = 512, OV = 640, OQI = 768, OKI = 1024, OWI = 1088, OGB = 1152, OGC = 1664, OHD = 2176;
constexpr float EPS = 1e-6f;
constexpr size_t OFF_YP = 0, OFF_YS = OFF_YP + (size_t)MP * DM, OFF_AKP = OFF_YS + (size_t)MS * DM, OFF_AVP = OFF_AKP + (size_t)2 * MP * 512,
    OFF_AKS = OFF_AVP + (size_t)2 * MP * 512, OFF_AVS = OFF_AKS + (size_t)2 * MS * 512, OFF_BVS = OFF_AVS + (size_t)2 * MS * 512,
    OFF_CKP = OFF_BVS + (size_t)2 * MS * 512, OFF_CVP = OFF_CKP + (size_t)2 * MP * 128, OFF_CIP = OFF_CVP + (size_t)2 * MP * 128,
    OFF_CKS = OFF_CIP + (size_t)2 * MP * 64, OFF_CVS = OFF_CKS + (size_t)2 * MS * 128, OFF_CIS = OFF_CVS + (size_t)2 * MS * 128,
    OFF_DCP = OFF_CIS + (size_t)2 * MS * 64, OFF_DCS = OFF_DCP + (size_t)2 * 8 * 2 * 512, OUT_TOTAL = OFF_DCS + (size_t)2 * 8 * 2 * 512;
static_assert(OUT_TOTAL == 62062592, "output size");
constexpr size_t MiB = 1u << 20;
constexpr size_t WS_WINE = 0, WS_WINO = 10 * MiB, WS_WOUT = 21 * MiB, WS_W1 = 29 * MiB, WS_W2 = 61 * MiB, WS_H = 93 * MiB, WS_ACT = 126 * MiB,
    WS_Z = 126 * MiB, WS_CAT = 216 * MiB, WS_END = 256 * MiB,
    WS_VTP = 256 * MiB  , WS_KS = 261 * MiB  , WS_VTS = 264 * MiB  ,
    WS_KIS = 267 * MiB  , WS_VTA = 269 * MiB  , WS_KSA = 286 * MiB  ,
    WS_VTSA = 295 * MiB  , WS_CTL = 304 * MiB  , WS_END2 = 305 * MiB;
constexpr int VTL = 2112;
constexpr size_t CTL_BYTES = 16384;
constexpr size_t WS_WSB = WS_CTL + 65536;
constexpr int LDS_BARST = 143360;
constexpr int SKL = 1088;
static_assert(WS_WINE + (size_t)2 * EVEN_IN * DM * 2 <= WS_WINO && WS_WINO + (size_t)2 * ODD_IN * DM * 2 <= WS_WOUT && WS_H + (size_t)MT * DM * 2 <= WS_ACT &&
              WS_Z + (size_t)MT * ODD_IN * 2 <= WS_CAT && WS_CAT + (size_t)MT * DM * 2 <= WS_END && WS_ACT + (size_t)MT * FF * 2 <= WS_END, "ws map");
constexpr int LDS_BYTES = 147456;

struct Args { const float* in[24]; float* out; unsigned char* ws; int ph_lo, ph_hi; };
static_assert(sizeof(Args) == 216 && offsetof(Args, out) == 192 && offsetof(Args, ws) == 200, "Args layout (re-read from the kernarg segment by offset)");

__device__ __forceinline__ float bf2f(unsigned v) { return __uint_as_float(v << 16); }
__device__ __forceinline__ unsigned f2bf(float f) { unsigned u = __float_as_uint(f); return (u + 0x7fffu + ((u >> 16) & 1u)) >> 16; }
__device__ __forceinline__ unsigned pk2(float lo, float hi) { return f2bf(lo) | (f2bf(hi) << 16); }
__device__ __forceinline__ void unpack8(const u32x4 r, float (&f)[8]) {
    f[0] = __uint_as_float(r.x << 16); f[1] = __uint_as_float(r.x & 0xffff0000u); f[2] = __uint_as_float(r.y << 16); f[3] = __uint_as_float(r.y & 0xffff0000u);
    f[4] = __uint_as_float(r.z << 16); f[5] = __uint_as_float(r.z & 0xffff0000u); f[6] = __uint_as_float(r.w << 16); f[7] = __uint_as_float(r.w & 0xffff0000u); }
__device__ __forceinline__ u32x4 pack8(const float (&f)[8]) { u32x4 o; o.x = pk2(f[0], f[1]); o.y = pk2(f[2], f[3]); o.z = pk2(f[4], f[5]); o.w = pk2(f[6], f[7]); return o; }
__device__ __forceinline__ float wave_sum(float v) {
#pragma unroll
    for (int o = 1; o < 64; o <<= 1) v += __shfl_xor(v, o);
    return v; }
__device__ __forceinline__ float wave_max(float v) {
#pragma unroll
    for (int o = 1; o < 64; o <<= 1) v = fmaxf(v, __shfl_xor(v, o));
    return v; }
__device__ __forceinline__ int wave_sum_i(int v) {
#pragma unroll
    for (int o = 1; o < 64; o <<= 1) v += __shfl_xor(v, o);
    return v; }
__device__ __forceinline__ int wave_count(int c) {
    c += __builtin_amdgcn_update_dpp(0, c, 0x111, 0xf, 0xf, true);
    c += __builtin_amdgcn_update_dpp(0, c, 0x112, 0xf, 0xf, true);
    c += __builtin_amdgcn_update_dpp(0, c, 0x114, 0xf, 0xf, true);
    c += __builtin_amdgcn_update_dpp(0, c, 0x118, 0xf, 0xf, true);
    return __builtin_amdgcn_readlane(c, 15) + __builtin_amdgcn_readlane(c, 31) + __builtin_amdgcn_readlane(c, 47) + __builtin_amdgcn_readlane(c, 63);
}
#define LDS_WAIT() asm volatile("s_waitcnt lgkmcnt(0)" ::: "memory")
__device__ __forceinline__ float gelu_tanh(float x) {
    const float u2 = -1.5957691216057308f * (x + 0.044715f * x * x * x); return x * __builtin_amdgcn_rcpf(1.f + __expf(u2)); }

__device__ __forceinline__ void transpose_item(const float* W, int K, int Nsrc, bf16* WT, int nblk, int mode, LAS float* scr, int item, int lane) {
    const int kb = item / nblk, nb = item % nblk, k0 = 64 * kb, n0 = 32 * nb;
    const int nd = n0 + (lane & 31);
    int src = nd;
    if (mode == 1) src = nd < 1092 ? nd : (nd < 1152 ? -1 : (nd < 2688 ? nd - 60 : -1));
#pragma unroll 8
    for (int i = 0; i < 32; ++i) { const int kk = 2 * i + (lane >> 5); scr[kk * 33 + (lane & 31)] = (src >= 0) ? __builtin_nontemporal_load(&W[(size_t)(k0 + kk) * Nsrc + src]) : 0.f; }
    LDS_WAIT();
    const int c = lane & 7;
#pragma unroll
    for (int jn = 0; jn < 4; ++jn) { const int n = (lane >> 3) + 8 * jn; const LAS float* s = scr + (8 * c) * 33 + n;
        u32x4 o; o.x = pk2(s[0 * 33], s[1 * 33]); o.y = pk2(s[2 * 33], s[3 * 33]); o.z = pk2(s[4 * 33], s[5 * 33]); o.w = pk2(s[6 * 33], s[7 * 33]);
        *(u32x4*)(WT + (size_t)(n0 + n) * K + k0 + 8 * c) = o; }
    LDS_WAIT();
}
__device__ __forceinline__ void norm_row(const float* xrow, const float* g, bf16* orow, float* xcopy, int lane) {
    const f32x4* xr = (const f32x4*)xrow + lane; f32x4 v[4]; float s = 0.f;
#pragma unroll
    for (int q = 0; q < 4; ++q) { v[q] = __builtin_nontemporal_load(&xr[64 * q]); s += (v[q].x * v[q].x + v[q].y * v[q].y) + (v[q].z * v[q].z + v[q].w * v[q].w); }
    const float r = rsqrtf(wave_sum(s) * (1.f / 1024.f) + EPS);
    const f32x4* gr = (const f32x4*)g + lane;
    unsigned long long* o8 = (unsigned long long*)orow + lane;
#pragma unroll
    for (int q = 0; q < 4; ++q) { const f32x4 gg = gr[64 * q]; const f32x4 y = v[q] * r * gg;
        o8[64 * q] = (unsigned long long)pk2(y.x, y.y) | ((unsigned long long)pk2(y.z, y.w) << 32);
        if (xcopy) ((f32x4*)xcopy)[lane + 64 * q] = v[q]; }
}
__device__ __forceinline__ void p_prologue(const Args& a, LAS unsigned char* lds, int gw, int NGW, int wave, int lane) {
    unsigned char* ws = a.ws;
    LAS float* scr = (LAS float*)(lds + wave * 16384);
    constexpr int I_E = 16 * 80, I_O = 16 * 88, I_W = 16 * 32, I_1 = 16 * 128, I_2 = 64 * 32;
    constexpr int NITEMS = 2 * I_E + 2 * I_O + 4 * I_W + 4 * I_1 + 4 * I_2;
    for (int it = gw; it < NITEMS; it += NGW) {
        int r = it;
        if (r < 2 * I_E) { const int j = r / I_E; transpose_item(a.in[10] + (size_t)j * DM * EVEN_IN, DM, EVEN_IN, (bf16*)(ws + WS_WINE) + (size_t)j * EVEN_IN * DM, 80, 0, scr, r % I_E, lane); continue; } r -= 2 * I_E;
        if (r < 2 * I_O) { const int j = r / I_O; transpose_item(a.in[17] + (size_t)j * DM * ODD_SRC, DM, ODD_SRC, (bf16*)(ws + WS_WINO) + (size_t)j * ODD_IN * DM, 88, 1, scr, r % I_O, lane); continue; } r -= 2 * I_O;
        if (r < 4 * I_W) { const int li = r / I_W; const float* src = ((li & 1) ? a.in[21] : a.in[16]) + (size_t)(li >> 1) * DM * DM;
            transpose_item(src, DM, DM, (bf16*)(ws + WS_WOUT) + (size_t)li * DM * DM, 32, 0, scr, r % I_W, lane); continue; } r -= 4 * I_W;
        if (r < 4 * I_1) { const int li = r / I_1; transpose_item(a.in[22] + (size_t)li * DM * FF, DM, FF, (bf16*)(ws + WS_W1) + (size_t)li * FF * DM, 128, 0, scr, r % I_1, lane); continue; } r -= 4 * I_1;
        { const int li = r / I_2; transpose_item(a.in[23] + (size_t)li * FF * DM, FF, DM, (bf16*)(ws + WS_W2) + (size_t)li * DM * FF, 32, 0, scr, r % I_2, lane); }
    }
    {
        bf16* wsb = (bf16*)(ws + WS_WSB);
        for (int e = gw * 64 + lane; e < 2 * 4 * 128 * 128; e += NGW * 64) { const int p = (e >> 7) & 127, q = e & 127; wsb[e] = (bf16)f2bf(((q >> 6) <= (p >> 6)) ? a.in[14][e] : 0.f); }
    }
    bf16* H = (bf16*)(ws + WS_H);
    for (int m = gw; m < MT; m += NGW) { const float* src = m < MP ? a.in[0] + (size_t)m * DM : a.in[1] + (size_t)(m - MP) * DM;
        norm_row(src, a.in[8], H + (size_t)m * DM, a.out + (size_t)m * DM, lane); }
}
__device__ __forceinline__ void norm_row2(const float* x0, const float* x1, const float* g, bf16* o0, bf16* o1, int lane) {
    const f32x4* xr0 = (const f32x4*)x0 + lane; const f32x4* xr1 = (const f32x4*)x1 + lane; f32x4 v0[4], v1[4]; float s0 = 0.f, s1 = 0.f;
#pragma unroll
    for (int q = 0; q < 4; ++q) { v0[q] = xr0[64 * q]; v1[q] = xr1[64 * q]; }
#pragma unroll
    for (int q = 0; q < 4; ++q) { s0 += (v0[q].x * v0[q].x + v0[q].y * v0[q].y) + (v0[q].z * v0[q].z + v0[q].w * v0[q].w); s1 += (v1[q].x * v1[q].x + v1[q].y * v1[q].y) + (v1[q].z * v1[q].z + v1[q].w * v1[q].w); }
#pragma unroll
    for (int o = 1; o < 64; o <<= 1) { s0 += __shfl_xor(s0, o); s1 += __shfl_xor(s1, o); }
    const float r0 = rsqrtf(s0 * (1.f / 1024.f) + EPS), r1 = rsqrtf(s1 * (1.f / 1024.f) + EPS);
    const f32x4* gr = (const f32x4*)g + lane;
    unsigned long long* p0 = (unsigned long long*)o0 + lane; unsigned long long* p1 = (unsigned long long*)o1 + lane;
#pragma unroll
    for (int q = 0; q < 4; ++q) { const f32x4 gg = gr[64 * q]; const f32x4 y0 = v0[q] * r0 * gg, y1 = v1[q] * r1 * gg;
        p0[64 * q] = (unsigned long long)pk2(y0.x, y0.y) | ((unsigned long long)pk2(y0.z, y0.w) << 32);
        p1[64 * q] = (unsigned long long)pk2(y1.x, y1.y) | ((unsigned long long)pk2(y1.z, y1.w) << 32); }
}
__device__ __forceinline__ void p_norm(const Args& a, const float* g, int gw, int NGW, int lane) {
    bf16* H = (bf16*)(a.ws + WS_H);
    for (int m = 2 * gw; m < MT; m += 2 * NGW) norm_row2(a.out + (size_t)m * DM, a.out + (size_t)(m + 1) * DM, g, H + (size_t)m * DM, H + (size_t)(m + 1) * DM, lane);
}

__device__ __forceinline__ void store8f(float* p, const float (&f)[8]) {
    __builtin_nontemporal_store((f32x4){f[0], f[1], f[2], f[3]}, (f32x4*)p); __builtin_nontemporal_store((f32x4){f[4], f[5], f[6], f[7]}, (f32x4*)(p + 4)); }
struct EvRaw { u32x4 q, k, v, u, vb; };
__device__ __forceinline__ EvRaw even_load(const bf16* z, int lane) { EvRaw r; r.q = *(const u32x4*)(z + EQ + 8 * lane); r.k = *(const u32x4*)(z + EK + 8 * lane); r.v = *(const u32x4*)(z + EV + 8 * lane);
    r.u = *(const u32x4*)(z + EU + 8 * lane); r.vb = *(const u32x4*)(z + EVB + 8 * lane); return r; }
__device__ __forceinline__ void even_post_row(const Args& a, int j, int r, int lane, LAS bf16* vtl, bool to_lds, const EvRaw& raw) {
    bf16* z = (bf16*)(a.ws + WS_Z) + (size_t)r * EVEN_IN;
    const bool samp = r >= MP; const int rs = r - MP;
    const int d0 = (8 * lane) & 63;
    const u32x4 raw_q = raw.q, raw_k = raw.k, raw_v = raw.v, raw_u = raw.u, raw_vb = raw.vb;
    float gq8[8], gk8[8], gb8[8];
    { const float* p = a.in[11] + j * 64 + d0; const float* q = a.in[12] + j * 64 + d0; const float* s = a.in[13] + j * 512 + 8 * lane;
#pragma unroll
      for (int e = 0; e < 8; ++e) { gq8[e] = p[e]; gk8[e] = q[e]; gb8[e] = s[e]; } }
    float f[8];
    {
        unpack8(raw_q, f);
        float ss = 0.f;
#pragma unroll
        for (int e = 0; e < 8; ++e) ss += f[e] * f[e];
        ss += __shfl_xor(ss, 1); ss += __shfl_xor(ss, 2); ss += __shfl_xor(ss, 4);
        const float rn = rsqrtf(ss * (1.f / 64.f) + EPS);
#pragma unroll
        for (int e = 0; e < 8; ++e) f[e] = f[e] * rn * gq8[e];
        *(u32x4*)(z + EQ + 8 * lane) = pack8(f);
    }
    {
        unpack8(raw_k, f);
        float ss = 0.f;
#pragma unroll
        for (int e = 0; e < 8; ++e) ss += f[e] * f[e];
        ss += __shfl_xor(ss, 1); ss += __shfl_xor(ss, 2); ss += __shfl_xor(ss, 4);
        const float rn = rsqrtf(ss * (1.f / 64.f) + EPS);
#pragma unroll
        for (int e = 0; e < 8; ++e) f[e] = f[e] * rn * gk8[e];
        *(u32x4*)(z + EK + 8 * lane) = pack8(f);
        if (samp) *(u32x4*)((bf16*)(a.ws + WS_KSA) + ((size_t)(rs / ST) * SKL + PAST + (rs % ST)) * 512 + 8 * lane) = pack8(f);
        float* o = samp ? a.out + OFF_AKS + (size_t)j * MS * 512 + (size_t)rs * 512 : a.out + OFF_AKP + (size_t)j * MP * 512 + (size_t)r * 512;
        store8f(o + 8 * lane, f);
    }
    {
        unpack8(raw_v, f);
        float* o = samp ? a.out + OFF_AVS + (size_t)j * MS * 512 + (size_t)rs * 512 : a.out + OFF_AVP + (size_t)j * MP * 512 + (size_t)r * 512;
        store8f(o + 8 * lane, f);
        if (to_lds) *(LAS u32x4*)(vtl + 8 * lane) = pack8(f);
        else {
            const int hh = lane >> 3;
            bf16* vt; size_t vs;
            if (samp) { vs = SKL; vt = (bf16*)(a.ws + WS_VTSA) + ((size_t)((rs / ST) * 8 + hh) * 64 + d0) * SKL + PAST + (rs % ST); }
            else { vs = VTL; vt = (bf16*)(a.ws + WS_VTA) + ((size_t)((r / SEQ) * 8 + hh) * 64 + d0) * VTL + (r % SEQ); }
#pragma unroll
            for (int e = 0; e < 8; ++e) vt[(size_t)e * vs] = (bf16)f2bf(f[e]);
        }
    }
    {
        unpack8(raw_u, f);
#pragma unroll
        for (int e = 0; e < 8; ++e) f[e] = gelu_tanh(f[e]);
        *(u32x4*)(z + EU + 8 * lane) = pack8(f);
    }
    {
        unpack8(raw_vb, f);
        float ss = 0.f;
#pragma unroll
        for (int e = 0; e < 8; ++e) { f[e] = gelu_tanh(f[e]); ss += f[e] * f[e]; }
        const float rn = rsqrtf(wave_sum(ss) * (1.f / 512.f) + EPS);
#pragma unroll
        for (int e = 0; e < 8; ++e) f[e] = f[e] * rn * gb8[e];
        *(u32x4*)(z + EVB + 8 * lane) = pack8(f);
        if (samp) store8f(a.out + OFF_BVS + (size_t)j * MS * 512 + (size_t)rs * 512 + 8 * lane, f);
    }
}
__device__ __forceinline__ void cin8(const bf16* zrow, int lane, float (&c)[8]) {
    float gc[8], hd[8]; unpack8(*(const u32x4*)(zrow + OGC + 8 * lane), gc); unpack8(*(const u32x4*)(zrow + OHD + 8 * lane), hd);
#pragma unroll
    for (int e = 0; e < 8; ++e) c[e] = gc[e] * hd[e];
}
struct OdRaw { u32x4 q, gb; unsigned k, v, ki; float c2[8], c1[8], c0[8]; };
__device__ __forceinline__ void odd_load(const Args& a, int j, int r, int lane, OdRaw& R) {
    const bf16* z = (const bf16*)(a.ws + WS_Z) + (size_t)r * ODD_IN;
    const bool samp = r >= MP; const int rs = r - MP;
    const int b = samp ? rs / ST : r / SEQ, t = samp ? rs % ST : r % SEQ;
    R.q = *(const u32x4*)(z + OQ + 8 * lane); R.gb = *(const u32x4*)(z + OGB + 8 * lane);
    R.k = *(const unsigned*)(z + OK + 2 * lane); R.v = *(const unsigned*)(z + OV + 2 * lane); R.ki = z[OKI + lane];
    cin8(z, lane, R.c2);
    const float* prev = a.in[7] + ((size_t)(j * 8 + b) * 2) * 512 + 8 * lane;
    if (t >= 1) cin8(z - ODD_IN, lane, R.c1);
    else {
#pragma unroll
        for (int e = 0; e < 8; ++e) R.c1[e] = samp ? prev[512 + e] : 0.f; }
    if (t >= 2) cin8(z - 2 * ODD_IN, lane, R.c0);
    else {
#pragma unroll
        for (int e = 0; e < 8; ++e) R.c0[e] = samp ? prev[t * 512 + e] : 0.f; }
}
__device__ __forceinline__ void odd_post_row(const Args& a, int j, int r, int lane, LAS bf16* vtl, bool to_lds, const OdRaw& R) {
    bf16* Zb = (bf16*)(a.ws + WS_Z);
    bf16* z = Zb + (size_t)r * ODD_IN;
    const bool samp = r >= MP; const int rs = r - MP;
    const int b = samp ? rs / ST : r / SEQ, t = samp ? rs % ST : r % SEQ, T = samp ? ST : SEQ;
    const u32x4 raw_q = R.q, raw_gb = R.gb; const unsigned raw_k = R.k, raw_v = R.v, raw_ki = R.ki;
    float c2[8], c1[8], c0[8];
#pragma unroll
    for (int e = 0; e < 8; ++e) { c2[e] = R.c2[e]; c1[e] = R.c1[e]; c0[e] = R.c0[e]; }
    float gq8[8], cw24[24]; float gk0, gk1;
    { const float* p = a.in[18] + j * 64 + ((8 * lane) & 63); const float* q = a.in[19] + j * 64 + ((2 * lane) & 63); const float* cwp = a.in[20] + (size_t)j * 3 * 512 + 8 * lane;
      gk0 = q[0]; gk1 = q[1];
#pragma unroll
      for (int e = 0; e < 8; ++e) { gq8[e] = p[e]; cw24[e] = cwp[e]; cw24[8 + e] = cwp[512 + e]; cw24[16 + e] = cwp[1024 + e]; } }
    float f[8];
    {
        unpack8(raw_q, f);
        float ss = 0.f;
#pragma unroll
        for (int e = 0; e < 8; ++e) ss += f[e] * f[e];
        ss += __shfl_xor(ss, 1); ss += __shfl_xor(ss, 2); ss += __shfl_xor(ss, 4);
        const float rn = rsqrtf(ss * (1.f / 64.f) + EPS);
#pragma unroll
        for (int e = 0; e < 8; ++e) f[e] = f[e] * rn * gq8[e];
        *(u32x4*)(z + OQ + 8 * lane) = pack8(f);
    }
    {
        const unsigned raw = raw_k;
        float k0 = __uint_as_float(raw << 16), k1 = __uint_as_float(raw & 0xffff0000u);
        float ss = k0 * k0 + k1 * k1;
        ss += __shfl_xor(ss, 1); ss += __shfl_xor(ss, 2); ss += __shfl_xor(ss, 4); ss += __shfl_xor(ss, 8); ss += __shfl_xor(ss, 16);
        const float rn = rsqrtf(ss * (1.f / 64.f) + EPS);
        k0 = k0 * rn * gk0; k1 = k1 * rn * gk1;
        *(unsigned*)(z + OK + 2 * lane) = pk2(k0, k1);
        if (samp) *(unsigned*)((bf16*)(a.ws + WS_KS) + ((size_t)b * SKL + PAST + t) * 128 + 2 * lane) = pk2(k0, k1);
        float* o = samp ? a.out + OFF_CKS + (size_t)j * MS * 128 + (size_t)rs * 128 : a.out + OFF_CKP + (size_t)j * MP * 128 + (size_t)r * 128;
        o[2 * lane] = k0; o[2 * lane + 1] = k1;
    }
    {
        const unsigned raw = raw_v;
        float* o = samp ? a.out + OFF_CVS + (size_t)j * MS * 128 + (size_t)rs * 128 : a.out + OFF_CVP + (size_t)j * MP * 128 + (size_t)r * 128;
        o[2 * lane] = __uint_as_float(raw << 16); o[2 * lane + 1] = __uint_as_float(raw & 0xffff0000u);
        const int gg = lane >> 5, dd = (2 * lane) & 63;
        if (to_lds) *(LAS unsigned*)(vtl + 2 * lane) = raw;
        else if (samp) { bf16* vt = (bf16*)(a.ws + WS_VTS) + ((size_t)(b * 2 + gg) * 64 + dd) * SKL + PAST + t; vt[0] = (bf16)(raw & 0xffffu); vt[SKL] = (bf16)(raw >> 16); }
        else { bf16* vt = (bf16*)(a.ws + WS_VTP) + ((size_t)(b * 2 + gg) * 64 + dd) * VTL + t; vt[0] = (bf16)(raw & 0xffffu); vt[VTL] = (bf16)(raw >> 16); }
    }
    {
        float* o = samp ? a.out + OFF_CIS + (size_t)j * MS * 64 + (size_t)rs * 64 : a.out + OFF_CIP + (size_t)j * MP * 64 + (size_t)r * 64;
        o[lane] = bf2f(raw_ki);
        if (samp) ((bf16*)(a.ws + WS_KIS))[((size_t)b * SKL + PAST + t) * 64 + lane] = (bf16)raw_ki;
    }
    {
        float gb[8];
        unpack8(raw_gb, gb);
#pragma unroll
        for (int e = 0; e < 8; ++e) f[e] = gb[e] * (cw24[e] * c0[e] + cw24[8 + e] * c1[e] + cw24[16 + e] * c2[e]);
        *(u32x4*)((bf16*)(a.ws + WS_CAT) + (size_t)r * DM + 512 + 8 * lane) = pack8(f);
        if (t >= T - 2) { const int slot = t - (T - 2);
            float* o = (samp ? a.out + OFF_DCS : a.out + OFF_DCP) + ((size_t)(j * 8 + b) * 2 + slot) * 512 + 8 * lane;
            store8f(o, c2); }
    }
}

__device__ __forceinline__ void sb_item(const Args& a, int j, int item, LAS unsigned char* lds, int tid, int w, int lane) {
    int b, h, zq_row0, nq, qpos0, P, zk_row0, kend;
    if (item < 2048) { b = item >> 8; h = (item >> 5) & 7; const int qt = item & 31; zq_row0 = b * SEQ + qt * 64; nq = 64; qpos0 = qt * 64; P = 0; zk_row0 = b * SEQ; kend = qpos0 + 64; }
    else { const int s = item - 2048; b = s >> 3; h = s & 7; zq_row0 = MP + b * ST; nq = ST; qpos0 = PAST; P = PAST; zk_row0 = MP + b * ST; kend = PAST + ST; }
    const bf16* Z = (const bf16*)(a.ws + WS_Z);
    LAS float* Qs = (LAS float*)lds;
    LAS float* Ks = Qs + 64 * 68;
    LAS float* Vs = Ks + 64 * 68;
    LAS float* Wm = Vs + 64 * 64;
    LAS int* flags = (LAS int*)(Wm + 64 * 64);
    __syncthreads();
    {
        const int qi = tid >> 3, dd = (tid & 7) * 8; float f[8];
        if (qi < nq) { unpack8(*(const u32x4*)(Z + (size_t)(zq_row0 + qi) * EVEN_IN + EQ + h * 64 + dd), f);
#pragma unroll
            for (int e = 0; e < 8; ++e) f[e] *= 0.125f; }
        else {
#pragma unroll
            for (int e = 0; e < 8; ++e) f[e] = 0.f; }
        *(LAS f32x4*)(Qs + qi * 68 + dd) = (f32x4){f[0], f[1], f[2], f[3]}; *(LAS f32x4*)(Qs + qi * 68 + dd + 4) = (f32x4){f[4], f[5], f[6], f[7]};
    }
    float carry[8], o[8];
#pragma unroll
    for (int i = 0; i < 8; ++i) { carry[i] = 0.f; o[i] = 0.f; }
    const int kt_hi = (kend - 1) >> 6;
    const float* cak = a.in[2]; const float* cav = a.in[3];
    for (int kt = kt_hi; kt >= 0; --kt) {
        __syncthreads();
        if (kt != kt_hi) { int all = 1;
#pragma unroll
            for (int x = 0; x < 8; ++x) all &= flags[x];
            if (all) break; }
        {
            const int key = tid >> 3, dd = (tid & 7) * 8, p = kt * 64 + key; float kf[8], vf[8];
            if (p < P) { const size_t off = (((size_t)(j * 8 + b) * PAST + p) * 8 + h) * 64 + dd;
                const f32x4 k0 = *(const f32x4*)(cak + off), k1 = *(const f32x4*)(cak + off + 4), v0 = *(const f32x4*)(cav + off), v1 = *(const f32x4*)(cav + off + 4);
                kf[0] = k0.x; kf[1] = k0.y; kf[2] = k0.z; kf[3] = k0.w; kf[4] = k1.x; kf[5] = k1.y; kf[6] = k1.z; kf[7] = k1.w;
                vf[0] = v0.x; vf[1] = v0.y; vf[2] = v0.z; vf[3] = v0.w; vf[4] = v1.x; vf[5] = v1.y; vf[6] = v1.z; vf[7] = v1.w; }
            else if (p < kend) { const bf16* zr = Z + (size_t)(zk_row0 + p - P) * EVEN_IN + h * 64 + dd;
                unpack8(*(const u32x4*)(zr + EK), kf); unpack8(*(const u32x4*)(zr + EV), vf); }
            else {
#pragma unroll
                for (int e = 0; e < 8; ++e) { kf[e] = 0.f; vf[e] = 0.f; } }
            *(LAS f32x4*)(Ks + key * 68 + dd) = (f32x4){kf[0], kf[1], kf[2], kf[3]}; *(LAS f32x4*)(Ks + key * 68 + dd + 4) = (f32x4){kf[4], kf[5], kf[6], kf[7]};
            *(LAS f32x4*)(Vs + key * 64 + dd) = (f32x4){vf[0], vf[1], vf[2], vf[3]}; *(LAS f32x4*)(Vs + key * 64 + dd + 4) = (f32x4){vf[4], vf[5], vf[6], vf[7]};
        }
        __syncthreads();
        float zz[8];
#pragma unroll
        for (int i = 0; i < 8; ++i) zz[i] = 0.f;
#pragma unroll 4
        for (int dq = 0; dq < 16; ++dq) { const f32x4 kv = *(const LAS f32x4*)(Ks + lane * 68 + 4 * dq);
#pragma unroll
            for (int i = 0; i < 8; ++i) { const f32x4 qv = *(const LAS f32x4*)(Qs + (w * 8 + i) * 68 + 4 * dq); zz[i] += (qv.x * kv.x + qv.y * kv.y) + (qv.z * kv.z + qv.w * kv.w); } }
        const int s = kt * 64 + lane;
#pragma unroll
        for (int i = 0; i < 8; ++i) {
            const int t = qpos0 + w * 8 + i; const bool valid = s < t; const float zv = zz[i];
            const float sp = fmaxf(zv, 0.f) + log1pf(expf(-fabsf(zv)));
            const float ls = valid ? -sp : 0.f;
            float v = ls;
#pragma unroll
            for (int off = 1; off < 64; off <<= 1) { const float t2 = __shfl_down(v, off); if (lane + off < 64) v += t2; }
            const float after = carry[i] + (v - ls);
            carry[i] += __shfl(v, 0);
            const float wgt = valid ? expf((zv - sp) + after) : 0.f;
            Wm[(w * 8 + i) * 64 + lane] = wgt;
        }
        LDS_WAIT();
#pragma unroll 2
        for (int s4 = 0; s4 < 16; ++s4) {
            const float v0 = Vs[(4 * s4 + 0) * 64 + lane], v1 = Vs[(4 * s4 + 1) * 64 + lane], v2 = Vs[(4 * s4 + 2) * 64 + lane], v3 = Vs[(4 * s4 + 3) * 64 + lane];
#pragma unroll
            for (int i = 0; i < 8; ++i) { const f32x4 wv = *(const LAS f32x4*)(Wm + (w * 8 + i) * 64 + 4 * s4); o[i] += (wv.x * v0 + wv.y * v1) + (wv.z * v2 + wv.w * v3); } }
        float mx = -1e30f;
#pragma unroll
        for (int i = 0; i < 8; ++i) if (w * 8 + i < nq) mx = fmaxf(mx, carry[i]);
        if (lane == 0) flags[w] = (mx < -110.f) ? 1 : 0;
    }
    bf16* CAT = (bf16*)(a.ws + WS_CAT);
#pragma unroll
    for (int i = 0; i < 8; ++i) { const int qi = w * 8 + i; if (qi < nq) CAT[(size_t)(zq_row0 + qi) * DM + h * 64 + lane] = (bf16)f2bf(o[i]); }
}
__device__ __forceinline__ void cache_a_row(const Args& a, int j, int bp, int lane, LAS bf16* vtl) {
    const int b = bp >> 10, p = bp & 1023;
    const float* ck = a.in[2] + ((size_t)(j * 8 + b) * PAST + p) * 512 + 8 * lane; const float* cv = a.in[3] + ((size_t)(j * 8 + b) * PAST + p) * 512 + 8 * lane;
    const f32x4 k0 = *(const f32x4*)ck, k1 = *(const f32x4*)(ck + 4), v0 = *(const f32x4*)cv, v1 = *(const f32x4*)(cv + 4);
    u32x4 pk; pk.x = pk2(k0.x, k0.y); pk.y = pk2(k0.z, k0.w); pk.z = pk2(k1.x, k1.y); pk.w = pk2(k1.z, k1.w);
    *(u32x4*)((bf16*)(a.ws + WS_KSA) + ((size_t)b * SKL + p) * 512 + 8 * lane) = pk;
    u32x4 pv; pv.x = pk2(v0.x, v0.y); pv.y = pk2(v0.z, v0.w); pv.z = pk2(v1.x, v1.y); pv.w = pk2(v1.z, v1.w);
    *(LAS u32x4*)(vtl + 8 * lane) = pv;
}
struct SbSrc { const bf16* kb; int ks; const bf16* vt; int vts; };
__device__ __forceinline__ void sb2_tile(const f32x4 z, int base, int t, int quad, float& carry, float (&wout)[4]) {
    float ls[4], lz[4]; bool valid[4];
#pragma unroll
    for (int jj = 0; jj < 4; ++jj) { const int key = base + quad * 4 + jj; valid[jj] = (key < t) && (key >= 0);
        const float zv = z[jj] * 0.125f; const float sp = fmaxf(zv, 0.f) + __logf(1.f + __expf(-fabsf(zv)));
        ls[jj] = valid[jj] ? -sp : 0.f; lz[jj] = zv - sp; }
    const float e3 = 0.f, e2 = ls[3], e1 = e2 + ls[2], e0 = e1 + ls[1], T = e0 + ls[0];
    const float t1 = __shfl_xor(T, 16), t2 = __shfl_xor(T, 32), t3 = __shfl_xor(T, 48);
    const float H = (((quad ^ 1) > quad) ? t1 : 0.f) + (((quad ^ 2) > quad) ? t2 : 0.f) + (((quad ^ 3) > quad) ? t3 : 0.f);
    const float ba = carry + H;
    wout[0] = valid[0] ? __expf(lz[0] + ba + e0) : 0.f; wout[1] = valid[1] ? __expf(lz[1] + ba + e1) : 0.f;
    wout[2] = valid[2] ? __expf(lz[2] + ba + e2) : 0.f; wout[3] = valid[3] ? __expf(lz[3] + ba + e3) : 0.f;
    carry += (T + t1) + (t2 + t3);
}
__device__ __forceinline__ void sb2_wave_item(const Args& a, const SbSrc src, int zq_row0, int hcol, int qpos0, int lane) {
    const bf16* Z = (const bf16*)(a.ws + WS_Z);
    const int n = lane & 15, quad = lane >> 4;
    const bf16* zr = Z + (size_t)(zq_row0 + n) * EVEN_IN + EQ + hcol + quad * 8;
    const bf16x8 bq0 = *(const bf16x8*)zr, bq1 = *(const bf16x8*)(zr + 32);
    const int t = qpos0 + n;
    float carry = 0.f;
    f32x4 oacc[4];
#pragma unroll
    for (int mt = 0; mt < 4; ++mt) oacc[mt] = (f32x4){0.f, 0.f, 0.f, 0.f};
    const bf16* vbase = src.vt + (size_t)n * src.vts + quad * 4;
    const bf16* kbase = src.kb + (size_t)n * src.ks + quad * 8;
    bf16x8 ak[4]; unsigned long long vv[8];
#define SB_LOAD(AK, VV, ub_) do { const int lbc_ = (ub_) - 16 < 0 ? 0 : (ub_) - 16; const bf16* kup = kbase + (size_t)(ub_) * src.ks; const bf16* klp = kbase + (size_t)lbc_ * src.ks; \
        AK[0] = *(const bf16x8*)kup; AK[1] = *(const bf16x8*)(kup + 32); AK[2] = *(const bf16x8*)klp; AK[3] = *(const bf16x8*)(klp + 32); \
        _Pragma("unroll") for (int mt = 0; mt < 4; ++mt) { const bf16* vp = vbase + (size_t)(16 * mt) * src.vts; VV[2 * mt] = *(const unsigned long long*)(vp + lbc_); VV[2 * mt + 1] = *(const unsigned long long*)(vp + (ub_)); } } while (0)
    SB_LOAD(ak, vv, qpos0);
#pragma unroll 1
    for (int ub = qpos0; ub >= 0; ub -= 32) {
        const int lb = ub - 16;
        bf16x8 akn[4]; unsigned long long vvn[8];
        { const int ubn = ub >= 32 ? ub - 32 : 0; SB_LOAD(akn, vvn, ubn); }
        f32x4 zu = (f32x4){0.f, 0.f, 0.f, 0.f}, zl = (f32x4){0.f, 0.f, 0.f, 0.f};
        zu = __builtin_amdgcn_mfma_f32_16x16x32_bf16(ak[0], bq0, zu, 0, 0, 0); zu = __builtin_amdgcn_mfma_f32_16x16x32_bf16(ak[1], bq1, zu, 0, 0, 0);
        zl = __builtin_amdgcn_mfma_f32_16x16x32_bf16(ak[2], bq0, zl, 0, 0, 0); zl = __builtin_amdgcn_mfma_f32_16x16x32_bf16(ak[3], bq1, zl, 0, 0, 0);
        float wu[4], wl[4];
        sb2_tile(zu, ub, t, quad, carry, wu);
        sb2_tile(zl, lb, t, quad, carry, wl);
        u32x4 pk; pk.x = pg8::cvt_pk_bf16(wl[0], wl[1]); pk.y = pg8::cvt_pk_bf16(wl[2], wl[3]); pk.z = pg8::cvt_pk_bf16(wu[0], wu[1]); pk.w = pg8::cvt_pk_bf16(wu[2], wu[3]);
        const bf16x8 pb = __builtin_bit_cast(bf16x8, pk);
#pragma unroll
        for (int mt = 0; mt < 4; ++mt) { const unsigned long long lo = vv[2 * mt], hi = vv[2 * mt + 1];
            u32x4 vk; vk.x = (unsigned)lo; vk.y = (unsigned)(lo >> 32); vk.z = (unsigned)hi; vk.w = (unsigned)(hi >> 32);
            oacc[mt] = __builtin_amdgcn_mfma_f32_16x16x32_bf16(__builtin_bit_cast(bf16x8, vk), pb, oacc[mt], 0, 0, 0); }
        if (__all(carry < -110.f)) break;
#pragma unroll
        for (int x = 0; x < 4; ++x) ak[x] = akn[x];
#pragma unroll
        for (int x = 0; x < 8; ++x) vv[x] = vvn[x];
    }
#undef SB_LOAD
    bf16* orow = (bf16*)(a.ws + WS_CAT) + (size_t)(zq_row0 + n) * DM + hcol + quad * 4;
#pragma unroll
    for (int mt = 0; mt < 4; ++mt) *(unsigned long long*)(orow + 16 * mt) = (unsigned long long)pk2(oacc[mt].x, oacc[mt].y) | ((unsigned long long)pk2(oacc[mt].z, oacc[mt].w) << 32);
}
__device__ __forceinline__ void gate_item(const Args& a, int j, int item, LAS unsigned char* lds, int tid) {
    int b, g, P, row0;
    if (item < 512) { b = item >> 6; const int n = (item >> 2) & 15; g = item & 3; P = 128; row0 = b * SEQ + n * 128; }
    else { const int s = item - 512; b = s >> 2; g = s & 3; P = ST; row0 = MP + b * ST; }
    bf16* Z = (bf16*)(a.ws + WS_Z);
    LAS float* Wt = (LAS float*)lds;
    LAS float* VB = Wt + 128 * 128;
    __syncthreads();
    const float* wsb = a.in[14] + (size_t)(j * 4 + g) * 128 * 128;
    for (int e = tid; e < 128 * 32; e += 512) { const int p = e >> 5, q4 = (e & 31) * 4; const f32x4 wv = *(const f32x4*)(wsb + p * 128 + q4);
#pragma unroll
        for (int k = 0; k < 4; ++k) { const int q = q4 + k; Wt[q * 128 + p] = ((q >> 6) <= (p >> 6)) ? wv[k] : 0.f; } }
    for (int e = tid; e < 128 * 16; e += 512) { const int q = e >> 4, c8 = (e & 15) * 8;
        if (q < P) { float f[8]; unpack8(*(const u32x4*)(Z + (size_t)(row0 + q) * EVEN_IN + EVB + g * 128 + c8), f);
            *(LAS f32x4*)(VB + q * 128 + c8) = (f32x4){f[0], f[1], f[2], f[3]}; *(LAS f32x4*)(VB + q * 128 + c8 + 4) = (f32x4){f[4], f[5], f[6], f[7]}; } }
    __syncthreads();
    const int p0 = (tid >> 4) * 4, c0 = (tid & 15) * 8;
    if (p0 < P) {
        float acc[4][8];
#pragma unroll
        for (int x = 0; x < 4; ++x)
#pragma unroll
            for (int y = 0; y < 8; ++y) acc[x][y] = 0.f;
#pragma unroll 4
        for (int q = 0; q < P; ++q) { const f32x4 wv = *(const LAS f32x4*)(Wt + q * 128 + p0), v0 = *(const LAS f32x4*)(VB + q * 128 + c0), v1 = *(const LAS f32x4*)(VB + q * 128 + c0 + 4);
#pragma unroll
            for (int x = 0; x < 4; ++x) { acc[x][0] += wv[x] * v0.x; acc[x][1] += wv[x] * v0.y; acc[x][2] += wv[x] * v0.z; acc[x][3] += wv[x] * v0.w;
                acc[x][4] += wv[x] * v1.x; acc[x][5] += wv[x] * v1.y; acc[x][6] += wv[x] * v1.z; acc[x][7] += wv[x] * v1.w; } }
        bf16* CAT = (bf16*)(a.ws + WS_CAT);
#pragma unroll
        for (int x = 0; x < 4; ++x) { const int p = p0 + x; const float bias = a.in[15][(j * 4 + g) * 128 + p]; const size_t row = (size_t)(row0 + p);
            float u[8], f[8]; unpack8(*(const u32x4*)(Z + row * EVEN_IN + EU + g * 128 + c0), u);
#pragma unroll
            for (int y = 0; y < 8; ++y) f[y] = u[y] * (acc[x][y] + bias);
            *(u32x4*)(CAT + row * DM + 512 + g * 128 + c0) = pack8(f); }
    }
}
__device__ __forceinline__ void cache_c_row(const Args& a, int j, int bp, int lane, LAS bf16* vtl) {
    const int b = bp >> 10, p = bp & 1023;
    const float* ck = a.in[4] + ((size_t)(j * 8 + b) * PAST + p) * 128; const float* cv = a.in[5] + ((size_t)(j * 8 + b) * PAST + p) * 128;
    const float* ci = a.in[6] + ((size_t)(j * 8 + b) * PAST + p) * 64;
    *(unsigned*)((bf16*)(a.ws + WS_KS) + ((size_t)b * SKL + p) * 128 + 2 * lane) = pk2(ck[2 * lane], ck[2 * lane + 1]);
    *(LAS unsigned*)(vtl + 2 * lane) = pk2(cv[2 * lane], cv[2 * lane + 1]);
    ((bf16*)(a.ws + WS_KIS))[((size_t)b * SKL + p) * 64 + lane] = (bf16)f2bf(ci[lane]);
}
template <int NR> __device__ __forceinline__ void dsa_select(const LAS float* Srow, int L, int lane2, LAS unsigned long long* bmk) {
    unsigned u[NR];
#pragma unroll
    for (int i = 0; i < NR; ++i) { const int key = lane2 + 64 * i; unsigned x = 0u;
        if (key < L) { const unsigned bits = __float_as_uint(Srow[key]); x = (bits & 0x80000000u) ? ~bits : (bits | 0x80000000u); }
        u[i] = x; }
    unsigned thr = 0u; int need = 0;
    if (L > 256) {
        bool exact = false;
        for (int bit = 31; bit >= 0; --bit) { const unsigned cand = thr | (1u << bit); int c = 0;
#pragma unroll
            for (int i = 0; i < NR; ++i) c += (u[i] >= cand) ? 1 : 0;
            c = wave_count(c);
            if (c >= 256) thr = cand;
            if (c == 256) { exact = true; break; } }
        if (exact) { thr -= 1u; need = 0; }
        else { int cgt = 0;
#pragma unroll
            for (int i = 0; i < NR; ++i) cgt += (u[i] > thr) ? 1 : 0;
            need = 256 - wave_count(cgt); }
    }
    const unsigned long long lt = (1ull << lane2) - 1ull;
    int tie_seen = 0;
#pragma unroll
    for (int i = 0; i < NR; ++i) {
        const bool gt = u[i] > thr, eq = (u[i] == thr) && (need > 0);
        const unsigned long long beq = __ballot(eq); const int rank = tie_seen + __popcll(beq & lt); tie_seen += __popcll(beq);
        const bool sel = gt || (eq && rank < need);
        const unsigned long long bs = __ballot(sel);
        if (lane2 == 0) bmk[i] = bs; }
}
struct DsaSrc { const bf16* kb; int ks; const bf16* kib; int kis; const bf16* vt; int vts; };
__device__ __forceinline__ void dsa2_item(const Args& a, const DsaSrc src, int zq_row0, int L, LAS unsigned char* lds, int w, int lane) {
    const bf16* Z = (const bf16*)(a.ws + WS_Z);
    constexpr int SSTR = 2048;
    LAS float* S = (LAS float*)lds;
    LAS unsigned long long* BMK = (LAS unsigned long long*)(lds + 131072);
    const int n = lane & 15, quad = lane >> 4, hn = n & 3;
#pragma unroll 1
    for (int r = 0; r < 2; ++r) {
        __syncthreads();
        {
            bf16x8 bq[4][2]; float wsc[4];
#pragma unroll
            for (int nt = 0; nt < 4; ++nt) { const bf16* zr = Z + (size_t)(zq_row0 + r * 16 + nt * 4 + (n >> 2)) * ODD_IN;
#pragma unroll
                for (int kk = 0; kk < 2; ++kk) bq[nt][kk] = *(const bf16x8*)(zr + OQI + hn * 64 + kk * 32 + quad * 8);
                wsc[nt] = bf2f(zr[OWI + hn]) * 0.0625f; }
            const int ntile = L >> 4;
            bf16x8 af0, af1;
            if (w < ntile) { const bf16* kr = src.kib + (size_t)(w * 16 + n) * src.kis + quad * 8; af0 = *(const bf16x8*)kr; af1 = *(const bf16x8*)(kr + 32); }
            for (int kt = w; kt < ntile; kt += 8) {
                const int ktn = (kt + 8 < ntile) ? kt + 8 : kt;
                const bf16* krn = src.kib + (size_t)(ktn * 16 + n) * src.kis + quad * 8;
                const bf16x8 an0 = *(const bf16x8*)krn, an1 = *(const bf16x8*)(krn + 32);
#pragma unroll
                for (int nt = 0; nt < 4; ++nt) { f32x4 acc = (f32x4){0.f, 0.f, 0.f, 0.f};
                    acc = __builtin_amdgcn_mfma_f32_16x16x32_bf16(af0, bq[nt][0], acc, 0, 0, 0);
                    acc = __builtin_amdgcn_mfma_f32_16x16x32_bf16(af1, bq[nt][1], acc, 0, 0, 0);
#pragma unroll
                    for (int jj = 0; jj < 4; ++jj) { float v = fmaxf(acc[jj], 0.f) * wsc[nt]; v += __shfl_xor(v, 1); v += __shfl_xor(v, 2); acc[jj] = v; }
                    if (hn == 0) *(LAS f32x4*)(S + (nt * 4 + (n >> 2)) * SSTR + kt * 16 + quad * 4) = acc; }
                af0 = an0; af1 = an1;
            }
        }
        __syncthreads();
        int lane2 = lane; asm volatile("" : "+v"(lane2));
#pragma unroll 1
        for (int qq = 0; qq < 2; ++qq) { const int ql = 2 * w + qq;
            if (L <= 512) dsa_select<8>(S + ql * SSTR, L, lane2, BMK + (r * 16 + ql) * 32);
            else if (L <= 1024) dsa_select<16>(S + ql * SSTR, L, lane2, BMK + (r * 16 + ql) * 32);
            else if (L <= 1536) dsa_select<24>(S + ql * SSTR, L, lane2, BMK + (r * 16 + ql) * 32);
            else dsa_select<32>(S + ql * SSTR, L, lane2, BMK + (r * 16 + ql) * 32);
        }
    }
    __syncthreads();
    for (int rep3_ = 0; rep3_ < REP_D3; ++rep3_)
    {
        int lane3 = lane; asm volatile("" : "+v"(lane3));
        const int n = lane3 & 15, quad = lane3 >> 4, hn = n & 3, lane_r = lane3;
        const int g = w >> 2, qh = (w >> 1) & 1, kh = w & 1;
        bf16x8 bqk[4][2];
#pragma unroll
        for (int nt = 0; nt < 4; ++nt) { const bf16* zr = Z + (size_t)(zq_row0 + 16 * qh + 4 * nt + (n >> 2)) * ODD_IN + OQ + (4 * g + hn) * 64 + quad * 8;
            bqk[nt][0] = *(const bf16x8*)zr; bqk[nt][1] = *(const bf16x8*)(zr + 32); }
        f32x4 oacc[4][4]; float lsum[4];
#pragma unroll
        for (int nt = 0; nt < 4; ++nt) { lsum[nt] = 0.f;
#pragma unroll
            for (int mt = 0; mt < 4; ++mt) oacc[mt][nt] = (f32x4){0.f, 0.f, 0.f, 0.f}; }
        const int n32 = L >> 5, smid = (n32 + 1) >> 1, s_begin = kh ? smid : 0, s_end = kh ? n32 : smid;
        const bf16* kbase = src.kb + (size_t)n * src.ks + g * 64 + quad * 8;
        const bf16* vbase = src.vt + (size_t)(g * 64 + n) * src.vts + quad * 4;
        bf16x8 ak[4];
#define DSA_LOADK(AK, s_) do { const bf16* k0p = kbase + (size_t)((s_) * 32) * src.ks; const bf16* k1p = k0p + (size_t)16 * src.ks; \
            AK[0] = *(const bf16x8*)k0p; AK[1] = *(const bf16x8*)(k0p + 32); AK[2] = *(const bf16x8*)k1p; AK[3] = *(const bf16x8*)(k1p + 32); } while (0)
        if (s_begin < s_end) DSA_LOADK(ak, s_begin);
#pragma unroll 1
        for (int s = s_begin; s < s_end; ++s) {
            unsigned long long vv[8];
#pragma unroll
            for (int mt = 0; mt < 4; ++mt) { const bf16* vp = vbase + (size_t)(16 * mt) * src.vts + s * 32; vv[2 * mt] = *(const unsigned long long*)vp; vv[2 * mt + 1] = *(const unsigned long long*)(vp + 16); }
            bf16x8 akn[4];
            { const int sn = (s + 1 < s_end) ? s + 1 : s; DSA_LOADK(akn, sn); }
            bf16x8 av[4];
#pragma unroll
            for (int mt = 0; mt < 4; ++mt) { u32x4 pk; pk.x = (unsigned)vv[2 * mt]; pk.y = (unsigned)(vv[2 * mt] >> 32); pk.z = (unsigned)vv[2 * mt + 1]; pk.w = (unsigned)(vv[2 * mt + 1] >> 32); av[mt] = __builtin_bit_cast(bf16x8, pk); }
#pragma unroll
            for (int nt = 0; nt < 4; ++nt) {
                f32x4 s0 = (f32x4){0.f, 0.f, 0.f, 0.f}, s1 = (f32x4){0.f, 0.f, 0.f, 0.f};
                s0 = __builtin_amdgcn_mfma_f32_16x16x32_bf16(ak[0], bqk[nt][0], s0, 0, 0, 0); s0 = __builtin_amdgcn_mfma_f32_16x16x32_bf16(ak[1], bqk[nt][1], s0, 0, 0, 0);
                s1 = __builtin_amdgcn_mfma_f32_16x16x32_bf16(ak[2], bqk[nt][0], s1, 0, 0, 0); s1 = __builtin_amdgcn_mfma_f32_16x16x32_bf16(ak[3], bqk[nt][1], s1, 0, 0, 0);
                const unsigned long long word = BMK[(16 * qh + 4 * nt + (n >> 2)) * 32 + (s >> 1)];
                const unsigned half = (unsigned)(word >> ((s & 1) * 32));
                const unsigned b0 = (half >> (quad * 4)) & 0xFu, b1 = (half >> (16 + quad * 4)) & 0xFu;
                float p0[4], p1[4];
#pragma unroll
                for (int jj = 0; jj < 4; ++jj) {
                    p0[jj] = ((b0 >> jj) & 1u) ? __builtin_amdgcn_exp2f(fminf(s0[jj] * 0.18033688f, 86.f)) : 0.f;
                    p1[jj] = ((b1 >> jj) & 1u) ? __builtin_amdgcn_exp2f(fminf(s1[jj] * 0.18033688f, 86.f)) : 0.f; }
                lsum[nt] += ((p0[0] + p0[1]) + (p0[2] + p0[3])) + ((p1[0] + p1[1]) + (p1[2] + p1[3]));
                u32x4 pk; pk.x = pg8::cvt_pk_bf16(p0[0], p0[1]); pk.y = pg8::cvt_pk_bf16(p0[2], p0[3]); pk.z = pg8::cvt_pk_bf16(p1[0], p1[1]); pk.w = pg8::cvt_pk_bf16(p1[2], p1[3]);
                const bf16x8 pb = __builtin_bit_cast(bf16x8, pk);
#pragma unroll
                for (int mt = 0; mt < 4; ++mt) oacc[mt][nt] = __builtin_amdgcn_mfma_f32_16x16x32_bf16(av[mt], pb, oacc[mt][nt], 0, 0, 0);
            }
#pragma unroll
            for (int x = 0; x < 4; ++x) ak[x] = akn[x];
        }
#undef DSA_LOADK
        LAS float* RED = (LAS float*)lds + (size_t)(w >> 1) * (68 * 64);
        if (kh == 1) {
#pragma unroll
            for (int mt = 0; mt < 4; ++mt)
#pragma unroll
                for (int nt = 0; nt < 4; ++nt)
#pragma unroll
                    for (int e = 0; e < 4; ++e) RED[((mt * 4 + nt) * 4 + e) * 64 + lane_r] = oacc[mt][nt][e];
#pragma unroll
            for (int nt = 0; nt < 4; ++nt) RED[(64 + nt) * 64 + lane_r] = lsum[nt];
        }
        __syncthreads();
        if (kh == 0) {
            bf16* CAT = (bf16*)(a.ws + WS_CAT);
#pragma unroll
            for (int nt = 0; nt < 4; ++nt) { float l = lsum[nt] + RED[(64 + nt) * 64 + lane_r]; l += __shfl_xor(l, 16); l += __shfl_xor(l, 32); const float inv = 1.f / l;
                bf16* orow = CAT + (size_t)(zq_row0 + 16 * qh + 4 * nt + (n >> 2)) * DM + (4 * g + hn) * 64 + quad * 4;
#pragma unroll
                for (int mt = 0; mt < 4; ++mt) { f32x4 o = oacc[mt][nt];
#pragma unroll
                    for (int e = 0; e < 4; ++e) o[e] = (o[e] + RED[((mt * 4 + nt) * 4 + e) * 64 + lane_r]) * inv;
                    *(unsigned long long*)(orow + 16 * mt) = (unsigned long long)pk2(o.x, o.y) | ((unsigned long long)pk2(o.z, o.w) << 32); } }
        }
    }
}
__device__ __forceinline__ void gate2_item(const Args& a, int j, int item, LAS unsigned char* lds, int tid, int w, int lane) {
    int b, g, P, row0;
    if (item < 512) { b = item >> 6; const int nn = (item >> 2) & 15; g = item & 3; P = 128; row0 = b * SEQ + nn * 128; }
    else { const int s = item - 512; b = s >> 2; g = s & 3; P = ST; row0 = MP + b * ST; }
    const bf16* Z = (const bf16*)(a.ws + WS_Z);
    constexpr int VP = 136;
    LAS bf16* VB = (LAS bf16*)lds;
    __syncthreads();
    for (int e = tid; e < P * 16; e += 512) { const int q = e >> 4, c8 = (e & 15) * 8;
        *(LAS u32x4*)(VB + q * VP + c8) = *(const u32x4*)(Z + (size_t)(row0 + q) * EVEN_IN + EVB + g * 128 + c8); }
    __syncthreads();
    const int n = lane & 15, quad = lane >> 4, c0 = 16 * w;
    const int nkk = P >> 5, npt = P >> 4;
    bf16x8 av[4];
#pragma unroll
    for (int kk = 0; kk < 4; ++kk) { unsigned pk[4] = {0u, 0u, 0u, 0u};
        if (kk < nkk) {
#pragma unroll
            for (int x = 0; x < 4; ++x) { const unsigned lo = VB[(kk * 32 + quad * 8 + 2 * x) * VP + c0 + n], hi = VB[(kk * 32 + quad * 8 + 2 * x + 1) * VP + c0 + n]; pk[x] = lo | (hi << 16); } }
        av[kk] = __builtin_bit_cast(bf16x8, (u32x4){pk[0], pk[1], pk[2], pk[3]}); }
    const bf16* wsb = (const bf16*)(a.ws + WS_WSB) + (size_t)(j * 4 + g) * 128 * 128;
    bf16* CAT = (bf16*)(a.ws + WS_CAT);
    f32x4 acc8[8]; unsigned long long ur8[8]; float bias8[8];
#pragma unroll
    for (int pt = 0; pt < 8; ++pt) { acc8[pt] = (f32x4){0.f, 0.f, 0.f, 0.f}; ur8[pt] = 0ull; bias8[pt] = 0.f;
        if (pt < npt) { const int p = 16 * pt + n; const size_t row = (size_t)(row0 + p);
            ur8[pt] = *(const unsigned long long*)(Z + row * EVEN_IN + EU + g * 128 + c0 + quad * 4); bias8[pt] = a.in[15][(j * 4 + g) * 128 + p];
#pragma unroll
            for (int kk = 0; kk < 4; ++kk) if (kk < nkk) { const bf16x8 bw = *(const bf16x8*)(wsb + p * 128 + kk * 32 + quad * 8);
                acc8[pt] = __builtin_amdgcn_mfma_f32_16x16x32_bf16(av[kk], bw, acc8[pt], 0, 0, 0); } } }
#pragma unroll
    for (int pt = 0; pt < 8; ++pt) if (pt < npt) {
        const int p = 16 * pt + n; const size_t row = (size_t)(row0 + p); const unsigned long long ur = ur8[pt]; const float bias = bias8[pt]; const f32x4 acc = acc8[pt];
        const float u0 = __uint_as_float((unsigned)ur << 16), u1 = __uint_as_float((unsigned)ur & 0xffff0000u), u2 = __uint_as_float((unsigned)(ur >> 32) << 16), u3 = __uint_as_float((unsigned)(ur >> 32) & 0xffff0000u);
        *(unsigned long long*)(CAT + row * DM + 512 + g * 128 + c0 + quad * 4) = (unsigned long long)pk2(u0 * (acc[0] + bias), u1 * (acc[1] + bias)) | ((unsigned long long)pk2(u2 * (acc[2] + bias), u3 * (acc[3] + bias)) << 32);
    }
}
__device__ __forceinline__ void dsa_item(const Args& a, int j, int b, int zq_row0, int L, int P, int zk_row0, LAS unsigned char* lds, int w, int lane) {
    const bf16* Z = (const bf16*)(a.ws + WS_Z);
    constexpr int SSTR = 2048;
    LAS float* S = (LAS float*)lds;
    LAS int* IDX = (LAS int*)(lds + 65536);
    LAS float* PS = (LAS float*)(lds + 73728);
    LAS float* QS = (LAS float*)(lds + 106496);
    const int n = lane & 15, quad = lane >> 4, hn = n & 3;
    __syncthreads();
    {
        bf16x8 bq[2][2]; float wsc[2];
#pragma unroll
        for (int nt = 0; nt < 2; ++nt) { const bf16* zr = Z + (size_t)(zq_row0 + nt * 4 + (n >> 2)) * ODD_IN;
#pragma unroll
            for (int kk = 0; kk < 2; ++kk) bq[nt][kk] = *(const bf16x8*)(zr + OQI + hn * 64 + kk * 32 + quad * 8);
            wsc[nt] = bf2f(zr[OWI + hn]) * 0.0625f; }
        const int ntile = L >> 4;
        const float* cki = a.in[6] + (size_t)(j * 8 + b) * PAST * 64;
        for (int kt = w; kt < ntile; kt += 8) {
            const int p = kt * 16 + n; bf16x8 af[2];
            if (p < P) { const float* src = cki + (size_t)p * 64 + quad * 8;
#pragma unroll
                for (int kk = 0; kk < 2; ++kk) { const f32x4 x0 = *(const f32x4*)(src + kk * 32), x1 = *(const f32x4*)(src + kk * 32 + 4);
                    u32x4 pk; pk.x = pk2(x0.x, x0.y); pk.y = pk2(x0.z, x0.w); pk.z = pk2(x1.x, x1.y); pk.w = pk2(x1.z, x1.w); af[kk] = __builtin_bit_cast(bf16x8, pk); } }
            else { const bf16* src = Z + (size_t)(zk_row0 + p - P) * ODD_IN + OKI + quad * 8;
#pragma unroll
                for (int kk = 0; kk < 2; ++kk) af[kk] = *(const bf16x8*)(src + kk * 32); }
#pragma unroll
            for (int nt = 0; nt < 2; ++nt) { f32x4 acc = (f32x4){0.f, 0.f, 0.f, 0.f};
                acc = __builtin_amdgcn_mfma_f32_16x16x32_bf16(af[0], bq[nt][0], acc, 0, 0, 0);
                acc = __builtin_amdgcn_mfma_f32_16x16x32_bf16(af[1], bq[nt][1], acc, 0, 0, 0);
#pragma unroll
                for (int jj = 0; jj < 4; ++jj) { float v = fmaxf(acc[jj], 0.f) * wsc[nt]; v += __shfl_xor(v, 1); v += __shfl_xor(v, 2); acc[jj] = v; }
                if (hn == 0) *(LAS f32x4*)(S + (nt * 4 + (n >> 2)) * SSTR + kt * 16 + quad * 4) = acc; }
        }
    }
    __syncthreads();
    int nsel;
    {
        unsigned u[32];
#pragma unroll
        for (int i = 0; i < 32; ++i) { const int key = lane + 64 * i; unsigned x = 0u;
            if (key < L) { const unsigned bits = __float_as_uint(S[w * SSTR + key]); x = (bits & 0x80000000u) ? ~bits : (bits | 0x80000000u); }
            u[i] = x; }
        unsigned thr = 0u; int need = 0;
        if (L > 256) {
            for (int bit = 31; bit >= 0; --bit) { const unsigned cand = thr | (1u << bit); int c = 0;
#pragma unroll
                for (int i = 0; i < 32; ++i) c += (u[i] >= cand) ? 1 : 0;
                c = wave_sum_i(c); if (c >= 256) thr = cand; }
            int cg = 0;
#pragma unroll
            for (int i = 0; i < 32; ++i) cg += (u[i] > thr) ? 1 : 0;
            cg = wave_sum_i(cg); need = 256 - cg;
        }
        const unsigned long long lt = (1ull << lane) - 1ull;
        int base = 0, tie_seen = 0;
#pragma unroll
        for (int i = 0; i < 32; ++i) { if (64 * i < L) { const int key = lane + 64 * i;
            const bool gt = u[i] > thr, eq = (u[i] == thr) && (need > 0);
            const unsigned long long beq = __ballot(eq); const int rank = tie_seen + __popcll(beq & lt); tie_seen += __popcll(beq);
            const bool sel = gt || (eq && rank < need);
            const unsigned long long bs = __ballot(sel);
            if (sel) IDX[w * 256 + base + __popcll(bs & lt)] = key;
            base += __popcll(bs); } }
        nsel = base;
    }
    LDS_WAIT();
    const size_t qrow = (size_t)(zq_row0 + w);
    const float* cck = a.in[4] + (size_t)(j * 8 + b) * PAST * 128; const float* ccv = a.in[5] + (size_t)(j * 8 + b) * PAST * 128;
    bf16* CAT = (bf16*)(a.ws + WS_CAT);
#pragma unroll 1
    for (int g = 0; g < 2; ++g) {
#pragma unroll
        for (int hh = 0; hh < 4; ++hh) QS[(w * 4 + hh) * 64 + lane] = bf2f(Z[qrow * ODD_IN + OQ + (4 * g + hh) * 64 + lane]) * 0.125f;
        LDS_WAIT();
        const int njb = (nsel + 63) >> 6;
#pragma unroll 1
        for (int jb = 0; jb < njb; ++jb) { const int jpos = lane + 64 * jb; const bool valid = jpos < nsel;
            float kf[64];
            const int p = valid ? IDX[w * 256 + jpos] : 0;
            if (p < P) { const float* src = cck + ((size_t)p * 2 + g) * 64;
#pragma unroll
                for (int x = 0; x < 16; ++x) { const f32x4 t4 = *(const f32x4*)(src + 4 * x); kf[4 * x] = t4.x; kf[4 * x + 1] = t4.y; kf[4 * x + 2] = t4.z; kf[4 * x + 3] = t4.w; } }
            else { const bf16* src = Z + (size_t)(zk_row0 + p - P) * ODD_IN + OK + g * 64;
#pragma unroll
                for (int x = 0; x < 8; ++x) { float t8[8]; unpack8(*(const u32x4*)(src + 8 * x), t8);
#pragma unroll
                    for (int e = 0; e < 8; ++e) kf[8 * x + e] = t8[e]; } }
            float d[4] = {0.f, 0.f, 0.f, 0.f};
#pragma unroll
            for (int dq = 0; dq < 16; ++dq)
#pragma unroll
                for (int hh = 0; hh < 4; ++hh) { const f32x4 qv = *(const LAS f32x4*)(QS + (w * 4 + hh) * 64 + 4 * dq);
                    d[hh] += (qv.x * kf[4 * dq] + qv.y * kf[4 * dq + 1]) + (qv.z * kf[4 * dq + 2] + qv.w * kf[4 * dq + 3]); }
            if (valid) *(LAS f32x4*)(PS + (w * 256 + jpos) * 4) = (f32x4){d[0], d[1], d[2], d[3]};
        }
        LDS_WAIT();
        {
            f32x4 m4 = (f32x4){-1e30f, -1e30f, -1e30f, -1e30f};
#pragma unroll 1
            for (int jb = 0; jb < njb; ++jb) { const int jpos = lane + 64 * jb; if (jpos < nsel) { const f32x4 l4 = *(const LAS f32x4*)(PS + (w * 256 + jpos) * 4);
                m4.x = fmaxf(m4.x, l4.x); m4.y = fmaxf(m4.y, l4.y); m4.z = fmaxf(m4.z, l4.z); m4.w = fmaxf(m4.w, l4.w); } }
            m4.x = wave_max(m4.x); m4.y = wave_max(m4.y); m4.z = wave_max(m4.z); m4.w = wave_max(m4.w);
            f32x4 s4 = (f32x4){0.f, 0.f, 0.f, 0.f};
#pragma unroll 1
            for (int jb = 0; jb < njb; ++jb) { const int jpos = lane + 64 * jb; if (jpos < nsel) { f32x4 l4 = *(const LAS f32x4*)(PS + (w * 256 + jpos) * 4);
                l4.x = expf(l4.x - m4.x); l4.y = expf(l4.y - m4.y); l4.z = expf(l4.z - m4.z); l4.w = expf(l4.w - m4.w); s4 += l4;
                *(LAS f32x4*)(PS + (w * 256 + jpos) * 4) = l4; } }
            s4.x = 1.f / wave_sum(s4.x); s4.y = 1.f / wave_sum(s4.y); s4.z = 1.f / wave_sum(s4.z); s4.w = 1.f / wave_sum(s4.w);
#pragma unroll 1
            for (int jb = 0; jb < njb; ++jb) { const int jpos = lane + 64 * jb; if (jpos < nsel) { f32x4 l4 = *(const LAS f32x4*)(PS + (w * 256 + jpos) * 4);
                *(LAS f32x4*)(PS + (w * 256 + jpos) * 4) = l4 * s4; } }
        }
        LDS_WAIT();
        float o0 = 0.f, o1 = 0.f, o2 = 0.f, o3 = 0.f;
#pragma unroll 4
        for (int jp = 0; jp < nsel; ++jp) { const int p = IDX[w * 256 + jp];
            const float vv = (p < P) ? ccv[((size_t)p * 2 + g) * 64 + lane] : bf2f(Z[(size_t)(zk_row0 + p - P) * ODD_IN + OV + g * 64 + lane]);
            const f32x4 pw = *(const LAS f32x4*)(PS + (w * 256 + jp) * 4);
            o0 += pw.x * vv; o1 += pw.y * vv; o2 += pw.z * vv; o3 += pw.w * vv; }
        bf16* orow = CAT + qrow * DM + (4 * g) * 64 + lane;
        orow[0] = (bf16)f2bf(o0); orow[64] = (bf16)f2bf(o1); orow[128] = (bf16)f2bf(o2); orow[192] = (bf16)f2bf(o3);
        LDS_WAIT();
    }
}


#ifndef REP_SYNC
#define REP_SYNC 1
#endif
#ifndef REP_NORM
#define REP_NORM 1
#endif
#ifndef REP_G0
#define REP_G0 1
#endif
#ifndef REP_G2
#define REP_G2 1
#endif
#ifndef REP_DSA
#define REP_DSA 1
#endif
#ifndef REP_SB
#define REP_SB 1
#endif
#ifndef REP_GATE
#define REP_GATE 1
#endif
#ifndef REP_PRO
#define REP_PRO 1
#endif
template <int MODE> __device__ __forceinline__ void small_gemm_piece(const bf16* A, int lda, const bf16* Bt, int ldb, int row0, int col0, int k0, int klen, void* O, int ldo, int w, int lane) {
    const int n = lane & 15, quad = lane >> 4;
    const bf16* ap = A + (size_t)(row0 + 16 * (w & 3) + n) * lda + k0 + quad * 8;
    const bf16* bp0 = Bt + (size_t)(col0 + 32 * (w >> 2) + n) * ldb + k0 + quad * 8; const bf16* bp1 = bp0 + (size_t)16 * ldb;
    f32x4 acc0 = (f32x4){0.f, 0.f, 0.f, 0.f}, acc1 = (f32x4){0.f, 0.f, 0.f, 0.f};
#pragma unroll 1
    for (int k = 0; k < klen; k += 128) {
        bf16x8 af[4], b0[4], b1[4];
#pragma unroll
        for (int x = 0; x < 4; ++x) { af[x] = *(const bf16x8*)(ap + k + 32 * x); b0[x] = *(const bf16x8*)(bp0 + k + 32 * x); b1[x] = *(const bf16x8*)(bp1 + k + 32 * x); }
#pragma unroll
        for (int x = 0; x < 4; ++x) { acc0 = __builtin_amdgcn_mfma_f32_16x16x32_bf16(af[x], b0[x], acc0, 0, 0, 0); acc1 = __builtin_amdgcn_mfma_f32_16x16x32_bf16(af[x], b1[x], acc1, 0, 0, 0); }
    }
    const int r = row0 + 16 * (w & 3) + quad * 4, c = col0 + 32 * (w >> 2) + n;
#pragma unroll
    for (int jj = 0; jj < 4; ++jj) {
        if (MODE == 0) { const float x0 = fmaxf(acc0[jj], 0.f), x1 = fmaxf(acc1[jj], 0.f); bf16* o = (bf16*)O + (size_t)(r + jj) * ldo + c; o[0] = (bf16)f2bf(x0 * x0); o[16] = (bf16)f2bf(x1 * x1); }
        else { float* o = (float*)O + (size_t)(r + jj) * ldo + c; atomicAdd(o, acc0[jj]); atomicAdd(o + 16, acc1[jj]); }
    }
}
template <int W> __device__ __forceinline__ void vt_tile_store(const LAS bf16* vt, bf16* dst, int pitch, int tid) {
    if (tid < W) {
        bf16* o = dst + (size_t)tid * pitch;
#pragma unroll
        for (int c8 = 0; c8 < 8; ++c8) { unsigned pk[4];
#pragma unroll
            for (int x = 0; x < 4; ++x) { const unsigned lo = vt[(c8 * 8 + 2 * x) * W + tid], hi = vt[(c8 * 8 + 2 * x + 1) * W + tid]; pk[x] = lo | (hi << 16); }
            *(u32x4*)(o + c8 * 8) = (u32x4){pk[0], pk[1], pk[2], pk[3]}; }
    }
}
#define XB_TMO      128
#define XB_XCNT(j)  (256  + 64 * (j))
#define XB_XSUB(j)  (1280 + 64 * (j))
#define XB_XGEN(j)  (2304 + 64 * (j))
#define XB_TOP      3328
#define XB_TOPGEN   3392
#define XCD_BAR_WORDS 3456
#define XB_SPIN_CAP (1u << 18)

__device__ __forceinline__ unsigned xb_ld(unsigned* p)              { return __hip_atomic_load(p, __ATOMIC_RELAXED, __HIP_MEMORY_SCOPE_AGENT); }
__device__ __forceinline__ unsigned xb_add(unsigned* p, unsigned v) { return __hip_atomic_fetch_add(p, v, __ATOMIC_RELAXED, __HIP_MEMORY_SCOPE_AGENT); }
__device__ __forceinline__ unsigned xb_xcc_id() { return (unsigned)__builtin_amdgcn_s_getreg((3 << 11) | 20) & 0xFu; }
#define XB_SPIN(cond, bar) do { unsigned _sp = 0; while (cond) { __builtin_amdgcn_s_sleep(1); \
    if ((++_sp & 255u) == 0u) { if (xb_ld(&(bar)[XB_TMO])) break; if (_sp > XB_SPIN_CAP) { atomicAdd(&(bar)[XB_TMO], 1u); break; } } } } while (0)

struct XcdBarrier {
    unsigned* bar; unsigned x;
    volatile LAS unsigned* st;
};

__device__ __forceinline__ XcdBarrier xcd_barrier_post(unsigned* bar, volatile LAS unsigned* st) {
    XcdBarrier b; b.bar = bar; b.x = xb_xcc_id(); b.st = st;
    if (threadIdx.x == 0) (void)xb_add(&bar[XB_XCNT(b.x)], 1u);
    return b;
}
__device__ __forceinline__ void xcd_barrier_complete(unsigned* bar, unsigned x, unsigned& nloc, unsigned& nx) {
    const unsigned G = gridDim.x * gridDim.y * gridDim.z;
    unsigned sum, cnt, mine, sp = 0u;
    for (;;) {
        sum = 0u; cnt = 0u; mine = 0u;
#pragma unroll
        for (unsigned j = 0; j < 16; ++j) { const unsigned c = xb_ld(&bar[XB_XCNT(j)]); sum += c; cnt += (c > 0u) ? 1u : 0u; mine = (j == x) ? c : mine; }
        if (sum == G) break;
        __builtin_amdgcn_s_sleep(1);
        if ((++sp & 255u) == 0u) { if (xb_ld(&bar[XB_TMO])) break; if (sp > XB_SPIN_CAP) { atomicAdd(&bar[XB_TMO], 1u); break; } }
    }
    nloc = mine > 0u ? mine : 1u; nx = cnt > 0u ? cnt : 1u;
}

__device__ __forceinline__ void xcd_barrier(const XcdBarrier& b) {
    asm volatile("s_waitcnt vmcnt(0)" ::: "memory");
    __syncthreads();
    if (threadIdx.x == 0) {
        unsigned* bar = b.bar;
        __builtin_amdgcn_s_waitcnt(0);
        unsigned nloc = b.st[0], nx = b.st[1];
        if (nloc == 0u) { xcd_barrier_complete(bar, b.x, nloc, nx); b.st[0] = nloc; b.st[1] = nx; }
        const unsigned old = xb_add(&bar[XB_XSUB(b.x)], 1u);
        const unsigned gen = old / nloc;
        if (old + 1u == (gen + 1u) * nloc) {
            __builtin_amdgcn_fence(__ATOMIC_RELEASE, "agent");
            asm volatile("s_waitcnt vmcnt(0)" ::: "memory");
            const unsigned og = xb_add(&bar[XB_TOP], 1u);
            const unsigned tg = og / nx;
            if (og + 1u == (tg + 1u) * nx) xb_add(&bar[XB_TOPGEN], 1u);
            else XB_SPIN(xb_ld(&bar[XB_TOPGEN]) == tg, bar);
            __builtin_amdgcn_fence(__ATOMIC_ACQUIRE, "agent");
            xb_add(&bar[XB_XGEN(b.x)], 1u);
            asm volatile("s_waitcnt vmcnt(0)" ::: "memory");
        } else {
            XB_SPIN(xb_ld(&bar[XB_XGEN(b.x)]) == gen, bar);
            __builtin_amdgcn_fence(__ATOMIC_ACQUIRE, "agent");
            asm volatile("s_waitcnt vmcnt(0)" ::: "memory");
        }
    }
    __syncthreads();
}

#ifndef PROBE_DUP_SUB
#define PROBE_DUP_SUB -1
#endif
constexpr int N_PHASES = 1 + 4 * (PROBE_DUP_SUB >= 0 ? 9 : 8);
__global__ void __launch_bounds__(512, 2) mega_fwd(Args a) {
    extern __shared__ __attribute__((aligned(16))) unsigned char lds_raw[];
    LAS unsigned char* lds = (LAS unsigned char*)lds_raw;
    cg::grid_group grid = cg::this_grid();
    const int G = gridDim.x;
    typedef const __attribute__((address_space(4))) unsigned char* kptr_t; typedef const float* cfp_t; typedef float* fp_t; typedef unsigned char* ucp_t;
    const kptr_t kp0 = (kptr_t)__builtin_amdgcn_kernarg_segment_ptr();
    unsigned char* ws0 = a.ws;
    if (threadIdx.x < 4) ((LAS unsigned*)(lds + LDS_BARST))[threadIdx.x] = 0u;
    __syncthreads();
    (void)xcd_barrier_post((unsigned*)(ws0 + WS_CTL), (volatile LAS unsigned*)(lds + LDS_BARST));
#pragma unroll 1
    for (int pi = a.ph_lo; pi < a.ph_hi; ++pi) {
#if PROBE_DUP_SUB >= 0
        int ph = pi; if (pi > 0) { const int l9 = (pi - 1) / 9, s9 = (pi - 1) % 9; ph = 1 + l9 * 8 + (s9 <= PROBE_DUP_SUB ? s9 : s9 - 1); }
#else
        const int ph = pi;
#endif
        kptr_t kp = kp0; asm volatile("" : "+s"(kp));
        Args al;
#pragma unroll
        for (int i = 0; i < 24; ++i) al.in[i] = *(const cfp_t __attribute__((address_space(4)))*)(kp + 8 * i);
        al.out = *(const fp_t __attribute__((address_space(4)))*)(kp + 192); al.ws = *(const ucp_t __attribute__((address_space(4)))*)(kp + 200);
        al.ph_lo = a.ph_lo; al.ph_hi = a.ph_hi;
        unsigned char* ws = al.ws;
        bf16* H = (bf16*)(ws + WS_H); bf16* Zb = (bf16*)(ws + WS_Z); bf16* CAT = (bf16*)(ws + WS_CAT); bf16* ACT = (bf16*)(ws + WS_ACT);
        int tid_l = threadIdx.x; asm volatile("" : "+v"(tid_l));
        const int tid = tid_l, lane = tid & 63, w = __builtin_amdgcn_readfirstlane(tid >> 6);
        const int gw = blockIdx.x * 8 + w, NGW = G * 8;
        if (ph == 0) { for (int rep_ = 0; rep_ < REP_PRO; ++rep_) { p_prologue(al, lds, gw, NGW, w, lane); } }
        else {
            const int li = (ph - 1) >> 3, sub = (ph - 1) & 7, j = li >> 1; const bool odd = li & 1;
            if (sub == 0) { for (int rep_ = 0; rep_ < REP_NORM; ++rep_) { if (li > 0) p_norm(al, al.in[8] + li * DM, gw, NGW, lane); } }
            else if (sub == 1) {
                const int N = odd ? ODD_IN : EVEN_IN;
                const bf16* Wt = odd ? (const bf16*)(ws + WS_WINO) + (size_t)j * ODD_IN * DM : (const bf16*)(ws + WS_WINE) + (size_t)j * EVEN_IN * DM;
                pg8::Gemm g{H, Wt, MT, N, DM}; pg8::StaticOrder S; S.init(MT, N, G, (int)blockIdx.x);
                pg8::EpiBf16<0> E{Zb, N};
                for (int rep_ = 0; rep_ < REP_G0; ++rep_) { pg8::gemm_phase<pg8::EpiBf16<0>, pg8::StaticOrder, true, true>(lds, g, S, E, w); }
                {
                    const int nwg = (MT / 256) * (N / 256), nfull = nwg / G, first_idle = nwg - nfull * G;
                    const int nidle = G - first_idle; LAS bf16* vts = (LAS bf16*)lds;
                    if ((int)blockIdx.x >= first_idle && nidle > 0) {
                        for (int tile = (int)blockIdx.x - first_idle; tile < 128; tile += nidle) { __syncthreads();
                            int lane_c = lane; asm volatile("" : "+v"(lane_c));
                            if (odd) {
#pragma unroll 1
                                for (int i = 0; i < 8; ++i) cache_c_row(al, j, tile * 64 + w * 8 + i, lane_c, vts + (w * 8 + i) * 128);
                                __syncthreads();
                                vt_tile_store<128>(vts, (bf16*)(ws + WS_VTS) + (size_t)(tile >> 4) * 2 * 64 * SKL + (tile & 15) * 64, SKL, tid);
                            } else {
#pragma unroll 1
                                for (int i = 0; i < 8; ++i) cache_a_row(al, j, tile * 64 + w * 8 + i, lane_c, vts + (w * 8 + i) * 512);
                                __syncthreads();
                                vt_tile_store<512>(vts, (bf16*)(ws + WS_VTSA) + (size_t)(tile >> 4) * 8 * 64 * SKL + (tile & 15) * 64, SKL, tid);
                            } }
                    }
                }
            }
            else if (sub == 2) {
                LAS bf16* vts = (LAS bf16*)lds;
                if (odd) {
                    int lane_o = lane; asm volatile("" : "+v"(lane_o));
                    for (int tile = blockIdx.x; tile < 256; tile += G) { __syncthreads();
                        OdRaw cur; odd_load(al, j, tile * 64 + w * 8, lane_o, cur);
#pragma unroll 1
                        for (int i = 0; i < 8; ++i) { OdRaw nx; odd_load(al, j, tile * 64 + w * 8 + (i < 7 ? i + 1 : i), lane_o, nx);
                            odd_post_row(al, j, tile * 64 + w * 8 + i, lane_o, vts + (w * 8 + i) * 128, true, cur); cur = nx; }
                        __syncthreads();
                        vt_tile_store<128>(vts, (bf16*)(ws + WS_VTP) + (size_t)(tile >> 5) * 2 * 64 * VTL + (tile & 31) * 64, VTL, tid); }
                    for (int r = MP + gw; r < MT; r += NGW) { OdRaw one; odd_load(al, j, r, lane_o, one); odd_post_row(al, j, r, lane_o, vts, false, one); }
                } else {
                    int lane_e = lane; asm volatile("" : "+v"(lane_e));
                    for (int tile = blockIdx.x; tile < 256; tile += G) { __syncthreads();
                        EvRaw cur = even_load(Zb + (size_t)(tile * 64 + w * 8) * EVEN_IN, lane_e);
#pragma unroll 1
                        for (int i = 0; i < 8; ++i) { const EvRaw nx = even_load(Zb + (size_t)(tile * 64 + w * 8 + (i < 7 ? i + 1 : i)) * EVEN_IN, lane_e);
                            even_post_row(al, j, tile * 64 + w * 8 + i, lane_e, vts + (w * 8 + i) * 512, true, cur); cur = nx; }
                        __syncthreads();
                        vt_tile_store<512>(vts, (bf16*)(ws + WS_VTA) + (size_t)(tile >> 5) * 8 * 64 * VTL + (tile & 31) * 64, VTL, tid); }
                    for (int r = MP + gw; r < MT; r += NGW) { const EvRaw one = even_load(Zb + (size_t)r * EVEN_IN, lane_e); even_post_row(al, j, r, lane_e, vts, false, one); }
                }
            }
            else if (sub == 3) {
                if (odd) {
                  for (int rep_ = 0; rep_ < REP_DSA; ++rep_) {
                    unsigned* ticket = (unsigned*)(ws + WS_CTL) + 3584 + 64 * (j + 2 * rep_);
                    volatile LAS int* nxt = (volatile LAS int*)(lds + LDS_BARST + 8);
                    for (;;) {
                        __syncthreads();
                        if (tid == 0) *nxt = (int)__hip_atomic_fetch_add(ticket, 1u, __ATOMIC_RELAXED, __HIP_MEMORY_SCOPE_AGENT);
                        __syncthreads();
                        const int t = *nxt;
                        if (t >= 520) break;
                        if (t >= 256 && t < 264) { const int b = t - 256;
                            DsaSrc src{(const bf16*)(ws + WS_KS) + (size_t)b * SKL * 128, 128, (const bf16*)(ws + WS_KIS) + (size_t)b * SKL * 64, 64, (const bf16*)(ws + WS_VTS) + (size_t)b * 2 * 64 * SKL, SKL};
                            dsa2_item(al, src, MP + b * ST, PAST + ST, lds, w, lane); }
                        else { const int kk = t < 256 ? t : t - 8; const int c = 31 - (kk >> 4), rem = kk & 15, b = rem >> 1, hf = rem & 1;
                            const bf16* zb = Zb + (size_t)b * SEQ * ODD_IN;
                            DsaSrc src{zb + OK, ODD_IN, zb + OKI, ODD_IN, (const bf16*)(ws + WS_VTP) + (size_t)b * 2 * 64 * VTL, VTL};
                            dsa2_item(al, src, b * SEQ + c * 64 + hf * 32, 64 * (c + 1), lds, w, lane); }
                    }
                  }
                } else {
                    for (int rep_ = 0; rep_ < REP_SB; ++rep_) {
                        unsigned* ticket = (unsigned*)(ws + WS_CTL) + 3840 + 64 * (j + 2 * rep_);
                        volatile LAS int* nxt = (volatile LAS int*)(lds + LDS_BARST + 8);
                        for (;;) {
                            __syncthreads();
                            if (tid == 0) *nxt = (int)__hip_atomic_fetch_add(ticket, 1u, __ATOMIC_RELAXED, __HIP_MEMORY_SCOPE_AGENT);
                            __syncthreads();
                            const int t = *nxt;
                            if (t >= 1040) break;
                            if (t < 16) { const int s = t * 8 + w, bh = s >> 1, hf = s & 1, b = bh >> 3, h = bh & 7;
                                SbSrc src{(const bf16*)(ws + WS_KSA) + (size_t)b * SKL * 512 + h * 64, 512, (const bf16*)(ws + WS_VTSA) + (size_t)bh * 64 * SKL, SKL};
                                sb2_wave_item(al, src, MP + b * ST + hf * 16, h * 64, PAST + hf * 16, lane); }
                            else { const int id = (t - 16) * 8 + w, bh = id >> 7, qt = 127 - (id & 127), b = bh >> 3, h = bh & 7;
                                SbSrc src{Zb + (size_t)b * SEQ * EVEN_IN + EK + h * 64, EVEN_IN, (const bf16*)(ws + WS_VTA) + (size_t)bh * 64 * VTL, VTL};
                                sb2_wave_item(al, src, b * SEQ + qt * 16, h * 64, qt * 16, lane); }
                        }
                    }
                    for (int rep_ = 0; rep_ < REP_GATE; ++rep_) { for (int it = blockIdx.x; it < 512 + 32; it += G) gate2_item(al, j, it, lds, tid, w, lane); }
                }
            }
            else if (sub == 4) {
                const bf16* Wo = (const bf16*)(ws + WS_WOUT) + (size_t)li * DM * DM;
                pg8::Gemm g{CAT, Wo, MP, DM, DM}; pg8::StaticOrder S; S.init(MP, DM, G, (int)blockIdx.x);
                pg8::EpiRes E{al.out, DM};
                pg8::gemm_phase<pg8::EpiRes, pg8::StaticOrder, true, true>(lds, g, S, E, w);
                for (int pc = blockIdx.x; pc < 256; pc += G) { const int st = pc >> 2, ks = pc & 3;
                    small_gemm_piece<1>(CAT, DM, Wo, DM, MP + (st >> 4) * 64, (st & 15) * 64, ks * 256, 256, al.out, DM, w, lane); }
            }
            else if (sub == 5) { for (int rep_ = 0; rep_ < REP_NORM; ++rep_) { p_norm(al, al.in[9] + li * DM, gw, NGW, lane); } }
            else if (sub == 6) {
                const bf16* W1 = (const bf16*)(ws + WS_W1) + (size_t)li * FF * DM;
                pg8::Gemm g{H, W1, MP, FF, DM}; pg8::StaticOrder S; S.init(MP, FF, G, (int)blockIdx.x);
                pg8::EpiBf16<2> E{ACT, FF};
                for (int rep_ = 0; rep_ < REP_G2; ++rep_) { pg8::gemm_phase<pg8::EpiBf16<2>, pg8::StaticOrder, true, true>(lds, g, S, E, w); }
                for (int pc = blockIdx.x; pc < 256; pc += G) small_gemm_piece<0>(H, DM, W1, DM, MP + (pc >> 6) * 64, (pc & 63) * 64, 0, DM, ACT, FF, w, lane);
            }
            else {
                const bf16* W2 = (const bf16*)(ws + WS_W2) + (size_t)li * DM * FF;
                pg8::Gemm g{ACT, W2, MP, DM, FF}; pg8::StaticOrder S; S.init(MP, DM, G, (int)blockIdx.x);
                pg8::EpiRes E{al.out, DM};
                pg8::gemm_phase<pg8::EpiRes, pg8::StaticOrder, true, true>(lds, g, S, E, w);
                for (int pc = blockIdx.x; pc < 256; pc += G) { const int st = pc >> 2, ks = pc & 3;
                    small_gemm_piece<1>(ACT, FF, W2, FF, MP + (st >> 4) * 64, (st & 15) * 64, ks * 1024, 1024, al.out, DM, w, lane); }
            }
        }
        if (pi + 1 < al.ph_hi) { for (int rep_ = 0; rep_ < REP_SYNC; ++rep_) { if (al.ph_lo < 0) grid.sync();   { XcdBarrier xb; xb.bar = (unsigned*)(ws + WS_CTL); xb.x = xb_xcc_id(); xb.st = (volatile LAS unsigned*)(lds + LDS_BARST); xcd_barrier(xb); } } }
    }
}

#ifndef MK_MULTI
#define MK_MULTI 0
#endif
extern "C" void kernel_launch(void* const* d_in, const int* in_sizes, int n_in, void* d_out, int out_size, void* d_ws, size_t ws_size, hipStream_t stream) {
    static int grid = 0;
    if (grid == 0) {
        int dev = 0, cus = 0, per_cu = 0;
        hipGetDevice(&dev); hipDeviceGetAttribute(&cus, hipDeviceAttributeMultiprocessorCount, dev);
        if (hipFuncSetAttribute((const void*)mega_fwd, hipFuncAttributeMaxDynamicSharedMemorySize, LDS_BYTES) != hipSuccess) fprintf(stderr, "kernel_launch: hipFuncSetAttribute failed\n");
        if (hipOccupancyMaxActiveBlocksPerMultiprocessor(&per_cu, (const void*)mega_fwd, 512, LDS_BYTES) != hipSuccess || per_cu < 1) { fprintf(stderr, "kernel_launch: occupancy query says %d\n", per_cu); per_cu = 1; }
        (void)hipGetLastError();
        if (cus <= 0) cus = 256;
        grid = cus;
        if (n_in != 24 || (size_t)out_size != OUT_TOTAL || ws_size < WS_END2) fprintf(stderr, "kernel_launch: unexpected sizes n_in %d out %d ws %zu\n", n_in, out_size, ws_size);
    }
    Args a{};
    for (int i = 0; i < 24; ++i) a.in[i] = (const float*)d_in[i];
    a.out = (float*)d_out; a.ws = (unsigned char*)d_ws;
#if MK_MULTI
    for (int ph = 0; ph < N_PHASES; ++ph) { if (ph == 1) continue; a.ph_lo = ph; a.ph_hi = ph + 1; hipLaunchKernelGGL(mega_fwd, dim3(grid), dim3(512), LDS_BYTES, stream, a); }
#else
    if (hipMemsetAsync((unsigned char*)d_ws + WS_CTL, 0, CTL_BYTES, stream) != hipSuccess) fprintf(stderr, "kernel_launch: memset failed\n");
    a.ph_lo = 0; a.ph_hi = N_PHASES;
    void* args[] = {&a};
    hipError_t e = hipLaunchCooperativeKernel((const void*)mega_fwd, dim3(grid), dim3(512), args, LDS_BYTES, stream);
    if (e != hipSuccess) fprintf(stderr, "kernel_launch: cooperative launch failed: %s (grid %d)\n", hipGetErrorString(e), grid);
#endif
}
```
